# Optimizing an MI355X kernel written in HIP

```python
import math, functools
import jax, jax.numpy as jnp
from jax import lax
import numpy as np

D_MODEL = 1024
BATCH = 32
SEQ = 256
DEPTH = 4
DEC_BATCH = 4
DEC_SEQ = 1024
PAST_LEN = 256

GRID_W = 64
N_HEADS = 8
QK_NOPE = 64
QK_ROPE = 32
V_HEAD = 64
KV_LORA = 256
Q_LORA = 384
MLA_W = N_HEADS * V_HEAD
LRU_W = 512
LRU_BLOCKS = 8
LRU_BD = LRU_W // LRU_BLOCKS
LRU_C = 8.0
CONV_W = 4
CONV_LEFT = 2
D_FF = 2816
IN_W = Q_LORA + KV_LORA + QK_ROPE + 2 * LRU_W
IN_SPLITS = (Q_LORA, Q_LORA + KV_LORA, Q_LORA + KV_LORA + QK_ROPE, Q_LORA + KV_LORA + QK_ROPE + LRU_W)
MIX_W = MLA_W + LRU_W
N_MOD = 9
ALPHA = (2.0 * DEPTH) ** 0.25
BETA = (8.0 * DEPTH) ** -0.25
ROPE_BASE = 10000.0
ATTN_SCALE = 1.0 / math.sqrt(QK_NOPE + QK_ROPE)
Q_BLOCK = 128
LN_EPS = 1e-5
RMS_EPS = 1e-6

kernel_name = "hybrid_mla_rglru_diffusion_step"


def layer_norm(x, g, b):
    xf = x.astype(jnp.float32)
    mu = jnp.mean(xf, axis=-1, keepdims=True)
    var = jnp.mean(jnp.square(xf - mu), axis=-1, keepdims=True)
    return ((xf - mu) * lax.rsqrt(var + LN_EPS)).astype(x.dtype) * g + b


def rms_norm(x, g):
    xf = x.astype(jnp.float32)
    ms = jnp.mean(jnp.square(xf), axis=-1, keepdims=True)
    return (xf * lax.rsqrt(ms + RMS_EPS)).astype(x.dtype) * g


def modulation(cond, w_mod, b_mod):
    m = jnp.einsum("bd,de->be", jax.nn.silu(cond), w_mod) + b_mod
    return m.reshape(cond.shape[0], N_MOD, D_MODEL)


def swiglu(h, w_up, w_down):
    u = jnp.einsum("btd,df->btf", h, w_up)
    return jnp.einsum("btf,fd->btd", jax.nn.silu(u[..., :D_FF]) * u[..., D_FF:], w_down)


def centred_dwconv(x, w, b):
    t = x.shape[1]
    xp = jnp.pad(x, ((0, 0), (CONV_LEFT, CONV_W - 1 - CONV_LEFT), (0, 0)))
    return sum(xp[:, k:k + t] * w[k] for k in range(CONV_W)) + b


def axial_rope_tables(rows, dtype):
    n_freq = QK_ROPE // 4
    inv = ROPE_BASE ** (-jnp.arange(n_freq, dtype=jnp.float32) / n_freq)
    row = jnp.repeat(jnp.arange(rows, dtype=jnp.float32), GRID_W)
    col = jnp.tile(jnp.arange(GRID_W, dtype=jnp.float32), rows)
    ang = jnp.concatenate([row[:, None] * inv, col[:, None] * inv], axis=-1)
    return jnp.cos(ang).astype(dtype), jnp.sin(ang).astype(dtype)


def apply_rope(x, cos, sin):
    half = QK_ROPE // 2
    x1, x2 = x[..., :half], x[..., half:]
    return jnp.concatenate([x1 * cos - x2 * sin, x1 * sin + x2 * cos], axis=-1)


def mixer_inputs(h, lp):
    b, t, _ = h.shape
    proj = jnp.einsum("btd,de->bte", h, lp["w_in"])
    c_q, c_kv, k_rope, u_x, u_g = jnp.split(proj, IN_SPLITS, axis=-1)
    q = jnp.einsum("btc,ce->bte", rms_norm(c_q, lp["q_norm_g"]), lp["w_uq"])
    q = q.reshape(b, t, N_HEADS, QK_NOPE + QK_ROPE)
    c_kv = rms_norm(c_kv, lp["kv_norm_g"])
    u_x = centred_dwconv(u_x, lp["conv_w"], lp["conv_b"])
    return q[..., :QK_NOPE], q[..., QK_NOPE:], c_kv, k_rope, u_x, u_g


def decompress_kv(c_kv, w_ukv):
    b, t, _ = c_kv.shape
    kv = jnp.einsum("btc,ce->bte", c_kv, w_ukv).reshape(b, t, N_HEADS, QK_NOPE + V_HEAD)
    return kv[..., :QK_NOPE], kv[..., QK_NOPE:]


def mla_attention(q_nope, q_rope, k_nope, k_rope, v):
    b, tq = q_nope.shape[:2]
    blk = math.gcd(tq, Q_BLOCK)
    nb = tq // blk

    def one_block(qs):
        qn, qr = qs
        s = jnp.einsum("bqhd,bkhd->bhqk", qn, k_nope) + jnp.einsum("bqhr,bkr->bhqk", qr, k_rope)
        p = jax.nn.softmax(s.astype(jnp.float32) * ATTN_SCALE, axis=-1).astype(v.dtype)
        return jnp.einsum("bhqk,bkhd->bqhd", p, v)

    qn_b = q_nope.reshape(b, nb, blk, N_HEADS, QK_NOPE).swapaxes(0, 1)
    qr_b = q_rope.reshape(b, nb, blk, N_HEADS, QK_ROPE).swapaxes(0, 1)
    o = lax.map(one_block, (qn_b, qr_b))
    return o.swapaxes(0, 1).reshape(b, tq, MLA_W)


def _linear_combine(e1, e2):
    a1, b1 = e1
    a2, b2 = e2
    return a1 * a2, a2 * b1 + b2


def rg_lru(x, w_a, b_a, w_x, b_x, lam, h0, reverse):
    b, t, _ = x.shape
    xb = x.reshape(b, t, LRU_BLOCKS, LRU_BD)
    r = jax.nn.sigmoid((jnp.einsum("btnd,nde->btne", xb, w_a).reshape(b, t, LRU_W) + b_a).astype(jnp.float32))
    i = jax.nn.sigmoid((jnp.einsum("btnd,nde->btne", xb, w_x).reshape(b, t, LRU_W) + b_x).astype(jnp.float32))
    log_a = -LRU_C * r * jax.nn.softplus(-lam.astype(jnp.float32))
    a = jnp.exp(log_a)
    u = jnp.sqrt(-jnp.expm1(2.0 * log_a)) * (i * x.astype(jnp.float32))
    if reverse:
        a, u = a[:, ::-1], u[:, ::-1]
    u = u.at[:, 0].add(a[:, 0] * h0.astype(jnp.float32))
    _, h = lax.associative_scan(_linear_combine, (a, u), axis=1)
    if reverse:
        h = h[:, ::-1]
    return h.astype(x.dtype)


def bidir_rg_lru(u_x, h0, lp):
    hf = rg_lru(u_x, lp["lru_w_a"][0], lp["lru_b_a"][0], lp["lru_w_x"][0], lp["lru_b_x"][0],
                lp["lru_lambda"][0], h0[:, 0], False)
    hb = rg_lru(u_x, lp["lru_w_a"][1], lp["lru_b_a"][1], lp["lru_w_x"][1], lp["lru_b_x"][1],
                lp["lru_lambda"][1], h0[:, 1], True)
    return hf, hb


def context_mixer(h, lp):
    q_nope, q_rope, c_kv, k_rope, u_x, u_g = mixer_inputs(h, lp)
    k_nope, v = decompress_kv(c_kv, lp["w_ukv"])
    att = mla_attention(q_nope, q_rope, k_nope, k_rope, v)
    h0 = jnp.zeros((h.shape[0], 2, LRU_W), jnp.float32)
    hf, hb = bidir_rg_lru(u_x, h0, lp)
    lru = (hf + hb) * jax.nn.gelu(u_g)
    y = jnp.einsum("bte,ed->btd", jnp.concatenate([att, lru], axis=-1), lp["w_o"])
    final_state = jnp.stack([hf[:, -1], hb[:, 0]], axis=1)
    return y, (c_kv, k_rope, final_state)


def latent_mixer(h, lp, ckv_ctx, krope_ctx, h0, cos, sin):
    q_nope, q_rope, c_kv, k_rope, u_x, u_g = mixer_inputs(h, lp)
    q_rope = apply_rope(q_rope, cos[None, :, None, :], sin[None, :, None, :])
    k_rope = apply_rope(k_rope, cos[None], sin[None])
    k_nope, v = decompress_kv(jnp.concatenate([ckv_ctx, c_kv], axis=1), lp["w_ukv"])
    k_rope = jnp.concatenate([krope_ctx, k_rope], axis=1)
    att = mla_attention(q_nope, q_rope, k_nope, k_rope, v)
    hf, hb = bidir_rg_lru(u_x, h0, lp)
    lru = (hf + hb) * jax.nn.gelu(u_g)
    y = jnp.einsum("bte,ed->btd", jnp.concatenate([att, lru], axis=-1), lp["w_o"])
    return y, None


def trunk_layer(x, mod, mixer, lp):
    m = [mod[:, k, None, :] for k in range(N_MOD)]
    h = x * (1 + m[1]) + m[0]
    x = layer_norm(ALPHA * x + 0.5 * m[2] * swiglu(h, lp["w_ffn_up"][0], lp["w_ffn_down"][0]),
                   lp["ln_g"][0], lp["ln_b"][0])
    h = x * (1 + m[4]) + m[3]
    y, aux = mixer(h)
    x = layer_norm(ALPHA * x + m[5] * y, lp["ln_g"][1], lp["ln_b"][1])
    h = x * (1 + m[7]) + m[6]
    x = layer_norm(ALPHA * x + 0.5 * m[8] * swiglu(h, lp["w_ffn_up"][1], lp["w_ffn_down"][1]),
                   lp["ln_g"][2], lp["ln_b"][2])
    return x, aux


def setup_inputs(seed: int = 0) -> dict:
    key = jax.random.key(seed)
    ks = iter(jax.random.split(key, 32))
    f32 = jnp.float32

    def nrm(shape, s):
        return jax.random.normal(next(ks), shape, f32) * s

    lam_u = jax.random.uniform(next(ks), (DEPTH, 2, LRU_W), f32, 0.9, 0.999)
    return {
        "x_prompt": nrm((BATCH, SEQ, D_MODEL), 1.0),
        "x_sample": nrm((DEC_BATCH, DEC_SEQ, D_MODEL), 1.0),
        "cache_ckv": nrm((DEC_BATCH, DEPTH, PAST_LEN, KV_LORA), 1.0),
        "cache_krope": nrm((DEC_BATCH, DEPTH, PAST_LEN, QK_ROPE), 1.0),
        "state_lru": nrm((DEC_BATCH, DEPTH, 2, LRU_W), 0.5),
        "c": nrm((DEC_BATCH, D_MODEL), 1.0),
        "c_ctx": nrm((D_MODEL,), 1.0),
        "w_mod": nrm((DEPTH, D_MODEL, N_MOD * D_MODEL), 0.5 * D_MODEL ** -0.5),
        "b_mod": nrm((DEPTH, N_MOD * D_MODEL), 0.02),
        "ln_g": 1.0 + nrm((DEPTH, 3, D_MODEL), 0.02),
        "ln_b": nrm((DEPTH, 3, D_MODEL), 0.02),
        "w_ffn_up": nrm((DEPTH, 2, D_MODEL, 2 * D_FF), D_MODEL ** -0.5),
        "w_ffn_down": nrm((DEPTH, 2, D_FF, D_MODEL), BETA * D_FF ** -0.5),
        "w_in": nrm((DEPTH, D_MODEL, IN_W), D_MODEL ** -0.5),
        "q_norm_g": 1.0 + nrm((DEPTH, Q_LORA), 0.02),
        "kv_norm_g": 1.0 + nrm((DEPTH, KV_LORA), 0.02),
        "w_uq": nrm((DEPTH, Q_LORA, N_HEADS * (QK_NOPE + QK_ROPE)), Q_LORA ** -0.5),
        "w_ukv": nrm((DEPTH, KV_LORA, N_HEADS * (QK_NOPE + V_HEAD)), KV_LORA ** -0.5),
        "conv_w": nrm((DEPTH, CONV_W, LRU_W), CONV_W ** -0.5),
        "conv_b": nrm((DEPTH, LRU_W), 0.02),
        "lru_w_a": nrm((DEPTH, 2, LRU_BLOCKS, LRU_BD, LRU_BD), LRU_BD ** -0.5),
        "lru_b_a": nrm((DEPTH, 2, LRU_W), 0.1),
        "lru_w_x": nrm((DEPTH, 2, LRU_BLOCKS, LRU_BD, LRU_BD), LRU_BD ** -0.5),
        "lru_b_x": nrm((DEPTH, 2, LRU_W), 0.1),
        "lru_lambda": jnp.log(lam_u) - jnp.log1p(-lam_u),
        "w_o": nrm((DEPTH, MIX_W, D_MODEL), BETA * MIX_W ** -0.5),
    }


def reference(x_prompt, x_sample, cache_ckv, cache_krope, state_lru, c, c_ctx, w_mod, b_mod,
              ln_g, ln_b, w_ffn_up, w_ffn_down, w_in, q_norm_g, kv_norm_g, w_uq, w_ukv,
              conv_w, conv_b, lru_w_a, lru_b_a, lru_w_x, lru_b_x, lru_lambda, w_o):
    rows = x_sample.shape[1] // GRID_W
    cos, sin = axial_rope_tables(rows, x_sample.dtype)
    xp, xs = x_prompt, x_sample
    ckv_out, krope_out, lru_out = [], [], []
    for l in range(DEPTH):
        lp = {
            "ln_g": ln_g[l], "ln_b": ln_b[l], "w_ffn_up": w_ffn_up[l], "w_ffn_down": w_ffn_down[l],
            "w_in": w_in[l], "q_norm_g": q_norm_g[l], "kv_norm_g": kv_norm_g[l],
            "w_uq": w_uq[l], "w_ukv": w_ukv[l], "conv_w": conv_w[l], "conv_b": conv_b[l],
            "lru_w_a": lru_w_a[l], "lru_b_a": lru_b_a[l], "lru_w_x": lru_w_x[l],
            "lru_b_x": lru_b_x[l], "lru_lambda": lru_lambda[l], "w_o": w_o[l],
        }
        mod_ctx = modulation(c_ctx[None, :], w_mod[l], b_mod[l])
        mod_lat = modulation(c, w_mod[l], b_mod[l])
        xp, (ckv, krope, st) = trunk_layer(xp, mod_ctx, functools.partial(context_mixer, lp=lp), lp)
        ckv_out.append(ckv)
        krope_out.append(krope)
        lru_out.append(st)
        lat_mixer = functools.partial(latent_mixer, lp=lp, ckv_ctx=cache_ckv[:, l],
                                      krope_ctx=cache_krope[:, l], h0=state_lru[:, l], cos=cos, sin=sin)
        xs, _ = trunk_layer(xs, mod_lat, lat_mixer, lp)
    new_cache_ckv = jnp.stack(ckv_out, axis=1)
    new_cache_krope = jnp.stack(krope_out, axis=1)
    new_state_lru = jnp.stack(lru_out, axis=1)
    return (xp, xs, new_cache_ckv, new_cache_krope, new_state_lru)
```

```cpp
#include <hip/hip_runtime.h>
#include <hip/hip_bf16.h>
#include <hip/hip_cooperative_groups.h>
#include <cstdio>
namespace cg = cooperative_groups;

typedef unsigned short u16;
using bf16x8 = __attribute__((ext_vector_type(8))) short;
using f32x4 = __attribute__((ext_vector_type(4))) float;
#define DEVI __device__ __forceinline__

constexpr int D = 1024, NTOK = 12288, NCTX = 8192, DFF = 2816, NLAYER = 4;
constexpr int NKV = 13312;
constexpr int PROJ_W = 1792;
constexpr float ALPHA_F = 1.681792830507429f;
constexpr float QSCALE = 0.10206207261596577f * 1.4426950408889634f;

constexpr size_t al256(size_t x) { return (x + 255) & ~(size_t)255; }
constexpr size_t OFF_MOD = 0;
constexpr size_t OFF_ROPE = OFF_MOD + al256((size_t)4 * 5 * 9216 * 4);
constexpr size_t OFF_WUP = OFF_ROPE + al256((size_t)1024 * 32 * 4);
constexpr size_t OFF_WDN = OFF_WUP + (size_t)8 * 5632 * 1024 * 2;
constexpr size_t OFF_WIN = OFF_WDN + (size_t)8 * 1024 * 2816 * 2;
constexpr size_t OFF_WUQ = OFF_WIN + (size_t)4 * 1792 * 1024 * 2;
constexpr size_t OFF_WUKV = OFF_WUQ + (size_t)4 * 768 * 384 * 2;
constexpr size_t OFF_WG = OFF_WUKV + (size_t)4 * 1024 * 256 * 2;
constexpr size_t OFF_WO = OFF_WG + (size_t)4 * 8 * 256 * 256 * 2;
constexpr size_t OFF_XRES = OFF_WO + (size_t)4 * 1024 * 1024 * 2;
constexpr size_t OFF_H = OFF_XRES + (size_t)NTOK * 1024 * 4;
constexpr size_t OFF_ACT = OFF_H + (size_t)NTOK * 1024 * 2;
constexpr size_t OFF_V = OFF_ACT + (size_t)4 * NTOK * 512 * 4;
constexpr size_t OFF_CQN = OFF_V + (size_t)NTOK * PROJ_W * 4;
constexpr size_t OFF_CKVN = OFF_CQN + (size_t)NTOK * 384 * 2;
constexpr size_t OFF_KR = OFF_CKVN + (size_t)NKV * 256 * 2;
constexpr size_t OFF_XC = OFF_KR + (size_t)NKV * 32 * 2;
constexpr size_t OFF_XCF = OFF_XC + (size_t)NTOK * 512 * 2;
constexpr size_t OFF_Q = OFF_XCF + (size_t)NTOK * 512 * 4;
constexpr size_t OFF_KN = OFF_Q + (size_t)NTOK * 768 * 2;
constexpr size_t OFF_VT = OFF_KN + (size_t)NKV * 512 * 2;
constexpr size_t OFF_MIX = OFF_VT + (size_t)NKV * 512 * 2;
constexpr size_t OFF_HF = OFF_MIX + (size_t)NTOK * 1024 * 2;
constexpr size_t OFF_BAR = OFF_HF + (size_t)NTOK * 512 * 4;
constexpr size_t OFF_STATS = OFF_BAR + 16384;
constexpr size_t WS_NEED = OFF_STATS + (size_t)NTOK * 4 * 8;
constexpr int LNCNT_WORD = 3520;

constexpr size_t OUT_CKV = 12582912, OUT_KROPE = 20971520, OUT_STATE = 22020096;

struct P {
  const float *x_prompt, *x_sample, *cache_ckv, *cache_krope, *state_lru, *c, *c_ctx, *w_mod, *b_mod, *ln_g, *ln_b,
      *w_up, *w_down, *w_in, *qg, *kvg, *w_uq, *w_ukv, *conv_w, *conv_b, *lru_w_a, *lru_b_a, *lru_w_x, *lru_b_x,
      *lru_lambda, *w_o;
  float* out;
  char* ws;
};

extern __shared__ __attribute__((aligned(16))) u16 shm[];

typedef __bf16 bf16x2_t __attribute__((ext_vector_type(2)));
typedef float f32x2_t __attribute__((ext_vector_type(2)));
DEVI unsigned pack2(float a, float b) {
  f32x2_t v = {a, b};
  bf16x2_t r = __builtin_convertvector(v, bf16x2_t);
  return *(unsigned*)&r;
}
DEVI u16 f2bf(float f) { return (u16)(pack2(f, 0.f) & 0xffffu); }
DEVI float sigmoid_f(float x) { return __builtin_amdgcn_rcpf(1.f + __expf(-x)); }
DEVI float silu_f(float x) { return x * __builtin_amdgcn_rcpf(1.f + __expf(-x)); }
DEVI float gelu_tanh(float x) {
  float y = 0.7978845608028654f * (x + 0.044715f * x * x * x);
  float t = 1.f - 2.f * __builtin_amdgcn_rcpf(1.f + __expf(2.f * y));
  return 0.5f * x * (1.f + t);
}
DEVI int lane_asm() {
  int l;
  asm volatile("v_mbcnt_lo_u32_b32 %0, -1, 0\n\tv_mbcnt_hi_u32_b32 %0, -1, %0" : "=v"(l));
  return l;
}
DEVI int get_tid(int wv_) { return wv_ * 64 + lane_asm(); }
DEVI float shfl_xor_f(float v, int o, int lane) {
  return __int_as_float(__builtin_amdgcn_ds_bpermute((lane ^ o) << 2, __float_as_int(v)));
}
DEVI float wave_sum(float v, int lane) {
#pragma unroll
  for (int o = 32; o > 0; o >>= 1) v += shfl_xor_f(v, o, lane);
  return v;
}
typedef unsigned uint2v_t __attribute__((ext_vector_type(2)));
DEVI float rows_max(float x) {
  uint2v_t r = __builtin_amdgcn_permlane16_swap(__float_as_uint(x), __float_as_uint(x), false, false);
  x = fmaxf(__uint_as_float(r[0]), __uint_as_float(r[1]));
  r = __builtin_amdgcn_permlane32_swap(__float_as_uint(x), __float_as_uint(x), false, false);
  return fmaxf(__uint_as_float(r[0]), __uint_as_float(r[1]));
}
DEVI float rows_sum(float x) {
  uint2v_t r = __builtin_amdgcn_permlane16_swap(__float_as_uint(x), __float_as_uint(x), false, false);
  x = __uint_as_float(r[0]) + __uint_as_float(r[1]);
  r = __builtin_amdgcn_permlane32_swap(__float_as_uint(x), __float_as_uint(x), false, false);
  return __uint_as_float(r[0]) + __uint_as_float(r[1]);
}
DEVI int cond_index(int r) { return r < NCTX ? 0 : 1 + ((r - NCTX) >> 10); }

constexpr int BK = 64, TILE_B = 256 * BK * 2, STAGE_B = 2 * TILE_B;

DEVI int lds_byte(int r, int c) {
  int st = (r >> 4) * 2 + (c >> 5), ob = (r & 15) * 64 + (c & 31) * 2;
  return st * 1024 + (ob ^ (((ob >> 9) & 1) << 5));
}
DEVI void stage_rc(int b, int& R, int& C) {
  int st = b >> 10, sb = b & 1023, swz = sb ^ (((sb >> 9) & 1) << 5);
  R = (st >> 1) * 16 + swz / 64;
  C = (st & 1) * 32 + (swz % 64) / 2;
}
#define WAIT_V(n) asm volatile("s_waitcnt vmcnt(%0)" ::"n"(n) : "memory")
#define SCHED() __builtin_amdgcn_sched_barrier(0)

template <int MT>
DEVI void gemm_stage0(int wv_, const u16* __restrict__ A, int lda, const u16* __restrict__ Bt, int ldb, int brow, int bcol) {
  char* sm = (char*)shm;
  const int tid = get_tid(wv_), wid = tid >> 6, lane = tid & 63;
  const u16* Ab = A + (long)brow * lda;
  const u16* Bb = Bt + (long)bcol * ldb;
#pragma unroll
  for (int i = 0; i < 4; ++i) {
    int r, c;
    stage_rc(wid * 1024 + i * 8192 + lane * 16, r, c);
    if (i < MT / 2)
      __builtin_amdgcn_global_load_lds((const unsigned*)(Ab + (long)r * lda + c),
                                       (unsigned*)(sm + wid * 1024 + i * 8192), 16, 0, 0);
    __builtin_amdgcn_global_load_lds((const unsigned*)(Bb + (long)r * ldb + c),
                                     (unsigned*)(sm + TILE_B + wid * 1024 + i * 8192), 16, 0, 0);
  }
}

template <int MT>
DEVI void gemm_core(int wv_, const u16* __restrict__ A, int lda, const u16* __restrict__ Bt, int ldb, int K, int brow,
                    int bcol, f32x4 (&acc)[MT][4]) {
  char* sm = (char*)shm;
  const int tid = get_tid(wv_), wid = tid >> 6, lane = tid & 63, wr = wid >> 2, wc = wid & 3, fr = lane & 15,
            fq = lane >> 4;
  const u16* Ab = A + (long)brow * lda;
  const u16* Bb = Bt + (long)bcol * ldb;
  long offA[MT / 2], offB[4];
#pragma unroll
  for (int i = 0; i < 4; ++i) {
    int r, c;
    stage_rc(wid * 1024 + i * 8192 + lane * 16, r, c);
    if (i < MT / 2) offA[i] = (long)r * lda + c;
    offB[i] = (long)r * ldb + c;
  }
#define GLDS_STAGE(buf, kt)                                                                                  \
  do {                                                                                                       \
    _Pragma("unroll") for (int i = 0; i < 4; ++i) {                                                          \
      if (i < MT / 2)                                                                                        \
        __builtin_amdgcn_global_load_lds((const unsigned*)(Ab + offA[i] + (kt)*BK),                          \
                                         (unsigned*)(sm + (buf)*STAGE_B + wid * 1024 + i * 8192), 16, 0, 0); \
      __builtin_amdgcn_global_load_lds((const unsigned*)(Bb + offB[i] + (kt)*BK),                            \
                                       (unsigned*)(sm + (buf)*STAGE_B + TILE_B + wid * 1024 + i * 8192), 16, 0, 0); \
    }                                                                                                        \
  } while (0)
#pragma unroll
  for (int m = 0; m < MT; ++m)
#pragma unroll
    for (int n = 0; n < 4; ++n) acc[m][n] = f32x4{0.f, 0.f, 0.f, 0.f};
  const int nt = K / BK;
  WAIT_V(0);
  __syncthreads();
  for (int t = 0; t < nt; ++t) {
    const int cur = t & 1;
    if (t + 1 < nt) GLDS_STAGE(cur ^ 1, t + 1);
#pragma unroll
    for (int ks = 0; ks < 2; ++ks) {
      bf16x8 At[MT], Bf[4];
#pragma unroll
      for (int m = 0; m < MT; ++m)
        At[m] = *(const bf16x8*)(sm + cur * STAGE_B + lds_byte(wr * (MT * 16) + m * 16 + fr, ks * 32 + fq * 8));
#pragma unroll
      for (int n = 0; n < 4; ++n)
        Bf[n] = *(const bf16x8*)(sm + cur * STAGE_B + TILE_B + lds_byte(wc * 64 + n * 16 + fr, ks * 32 + fq * 8));
#pragma unroll
      for (int m = 0; m < MT; ++m)
#pragma unroll
        for (int n = 0; n < 4; ++n)
          acc[m][n] = __builtin_amdgcn_mfma_f32_16x16x32_bf16(At[m], Bf[n], acc[m][n], 0, 0, 0);
      SCHED();
    }
    WAIT_V(0);
    __syncthreads();
  }
}

template <int MT>
DEVI void gemm_core_pipe(int wv_, const u16* __restrict__ A, int lda, const u16* __restrict__ Bt, int ldb, int K,
                         int brow, int bcol, f32x4 (&acc)[MT][4]) {
  char* sm = (char*)shm;
  const int tid = get_tid(wv_), wid = tid >> 6, lane = tid & 63, wr = wid >> 2, wc = wid & 3, fr = lane & 15,
            fq = lane >> 4;
  const u16* Ab = A + (long)brow * lda;
  const u16* Bb = Bt + (long)bcol * ldb;
  long offA[MT / 2], offB[4];
#pragma unroll
  for (int i = 0; i < 4; ++i) {
    int r, c;
    stage_rc(wid * 1024 + i * 8192 + lane * 16, r, c);
    if (i < MT / 2) offA[i] = (long)r * lda + c;
    offB[i] = (long)r * ldb + c;
  }
  const int a_off = lds_byte(wr * (MT * 16) + fr, fq * 8);
  const int b_off = TILE_B + lds_byte(wc * 64 + fr, fq * 8);
#define RFRAG(Fa, Fb, buf, ks)                                                                              \
  do {                                                                                                      \
    _Pragma("unroll") for (int m = 0; m < MT; ++m)                                                          \
      Fa[m] = *(const bf16x8*)(sm + (buf)*STAGE_B + a_off + m * 2048 + (ks)*1024);                         \
    _Pragma("unroll") for (int n = 0; n < 4; ++n)                                                           \
      Fb[n] = *(const bf16x8*)(sm + (buf)*STAGE_B + b_off + n * 2048 + (ks)*1024);                         \
  } while (0)
#define MMAS(Fa, Fb)                                                                                        \
  do {                                                                                                      \
    _Pragma("unroll") for (int m = 0; m < MT; ++m)                                                          \
      _Pragma("unroll") for (int n = 0; n < 4; ++n)                                                         \
        acc[m][n] = __builtin_amdgcn_mfma_f32_16x16x32_bf16(Fa[m], Fb[n], acc[m][n], 0, 0, 0);             \
  } while (0)
#pragma unroll
  for (int m = 0; m < MT; ++m)
#pragma unroll
    for (int n = 0; n < 4; ++n) acc[m][n] = f32x4{0.f, 0.f, 0.f, 0.f};
  const int nt = K / BK;
  bf16x8 A0[MT], B0[4], A1[MT], B1[4];
  WAIT_V(0);
  __syncthreads();
  if (nt > 1) GLDS_STAGE(1, 1);
  RFRAG(A0, B0, 0, 0);
  SCHED();
  for (int t = 0; t < nt; ++t) {
    const int cur = t & 1;
    RFRAG(A1, B1, cur, 1);
    SCHED();
    MMAS(A0, B0);
    SCHED();
    asm volatile("s_waitcnt lgkmcnt(0)" ::: "memory");
    WAIT_V(0);
    __syncthreads();
    if (t + 1 < nt) RFRAG(A0, B0, cur ^ 1, 0);
    SCHED();
    if (t + 2 < nt) GLDS_STAGE(cur, t + 2);
    MMAS(A1, B1);
    _Pragma("unroll") for (int g = 0; g < MT / 2 + 4; ++g) {
      __builtin_amdgcn_sched_group_barrier(0x008, 3, 0);
      __builtin_amdgcn_sched_group_barrier(0x006, 6, 0);
      __builtin_amdgcn_sched_group_barrier(0x020, 1, 0);
    }
    __builtin_amdgcn_sched_group_barrier(0x008, MT * 4 - 3 * (MT / 2 + 4), 0);
    SCHED();
  }
#undef RFRAG
#undef MMAS
}

enum { K_UP = 0, K_DOWN = 1, K_IN = 2, K_Q = 3, K_KV = 4, K_GATE = 5, K_O = 6 };

struct GemmDesc {
  const u16* A;
  const u16* B;
  int lda, ldb, K, nM, nN, kind;
};

template <int kind, int MT>
DEVI void gemm_epilogue(int wv_, const P& p, int l, int sub, int pm, int pn, f32x4 (&acc)[MT][4]) {
  const int tid_ = get_tid(wv_), wid = tid_ >> 6, lane = tid_ & 63, wr = wid >> 2, wc = wid & 3, fr = lane & 15,
            fq = lane >> 4;
  char* ws = p.ws;
  const int brow = pm * (MT * 32), bcol = pn * 256;
  const int row0 = brow + wr * (MT * 16) + fq * 4;
  if constexpr (kind == K_UP) {
    u16* act = (u16*)(ws + OFF_ACT) + (size_t)row0 * DFF + pn * 128 + wc * 32 + fr * 2;
#pragma unroll
    for (int m = 0; m < MT; ++m) {
#pragma unroll
      for (int j = 0; j < 4; ++j) {
        float v0 = silu_f(acc[m][0][j]) * acc[m][2][j];
        float v1 = silu_f(acc[m][1][j]) * acc[m][3][j];
        *(unsigned*)(act + (size_t)(m * 16 + j) * DFF) = pack2(v0, v1);
      }
      SCHED();
    }
  } else if constexpr (kind == K_DOWN || kind == K_O) {
    static_assert(MT == 6, "fused LN epilogue assumes 192-row tiles");
    const int gidx = (kind == K_O) ? 5 : (sub == 0 ? 2 : 8);
    const int lnidx = (kind == K_O) ? 1 : (sub == 0 ? 0 : 2);
    const float gs = (kind == K_O) ? 1.f : 0.5f;
    const int col = bcol + wc * 64 + fr * 4;
    const float* modb = (const float*)(ws + OFF_MOD);
    float* xres = (float*)(ws + OFF_XRES);
    float* lsm = (float*)shm;
    const int rl0 = wr * 96 + fq * 4;
    const bool first_in = (kind == K_DOWN) && (l == 0) && (sub == 0);
    const float* xin_lo = p.x_prompt;
    const float* xin_hi = p.x_sample - (size_t)NCTX * 1024;
#define XSRC(row) (first_in ? ((row) < NCTX ? xin_lo : xin_hi) : (const float*)xres)
    const int ci_lo = cond_index(brow), ci_hi = cond_index(brow + 191);
    const float4 gt_lo = *(const float4*)(modb + ((size_t)(l * 5 + ci_lo) * 9 + gidx) * 1024 + col);
    const float4 gt_hi = *(const float4*)(modb + ((size_t)(l * 5 + ci_hi) * 9 + gidx) * 1024 + col);
    {
      float4 xa[4], xb[4];
      int rowv = row0;
      asm volatile("" : "+v"(rowv));
#pragma unroll
      for (int j = 0; j < 4; ++j) xa[j] = *(const float4*)(XSRC(rowv + j) + (size_t)(rowv + j) * 1024 + col);
#pragma unroll
      for (int m = 0; m < MT; ++m) {
        const int rowm = rowv;
        if (m + 1 < MT) {
          rowv += 16;
          asm volatile("" : "+v"(rowv));
#pragma unroll
          for (int j = 0; j < 4; ++j) {
            const float4 t = *(const float4*)(XSRC(rowv + j) + (size_t)(rowv + j) * 1024 + col);
            if (m & 1) xa[j] = t; else xb[j] = t;
          }
        }
#pragma unroll
        for (int j = 0; j < 4; ++j) {
          const float4 xr = (m & 1) ? xb[j] : xa[j];
          const bool lo = cond_index(rowm + j) == ci_lo;
          float v0 = ALPHA_F * xr.x + gs * (lo ? gt_lo.x : gt_hi.x) * acc[m][0][j];
          float v1 = ALPHA_F * xr.y + gs * (lo ? gt_lo.y : gt_hi.y) * acc[m][1][j];
          float v2 = ALPHA_F * xr.z + gs * (lo ? gt_lo.z : gt_hi.z) * acc[m][2][j];
          float v3 = ALPHA_F * xr.w + gs * (lo ? gt_lo.w : gt_hi.w) * acc[m][3][j];
          acc[m][0][j] = v0; acc[m][1][j] = v1; acc[m][2][j] = v2; acc[m][3][j] = v3;
          float2 pr;
          pr.x = (v0 + v1) + (v2 + v3);
          pr.y = (v0 * v0 + v1 * v1) + (v2 * v2 + v3 * v3);
          *(float2*)(lsm + ((rl0 + m * 16 + j) * 65 + wc * 16 + fr) * 2) = pr;
        }
        SCHED();
      }
    }
    __syncthreads();
    unsigned long long* stats = (unsigned long long*)(ws + OFF_STATS);
    unsigned* cnt = (unsigned*)(ws + OFF_BAR) + LNCNT_WORD + pm;
    const int rr = tid_ >> 1, hh = tid_ & 1;
    if (tid_ < 384) {
      float s1 = 0.f, s2 = 0.f;
#pragma unroll 8
      for (int e = 0; e < 32; ++e) {
        float2 t = *(const float2*)(lsm + (rr * 65 + hh * 32 + e) * 2);
        s1 += t.x;
        s2 += t.y;
      }
      s1 += shfl_xor_f(s1, 1, lane);
      s2 += shfl_xor_f(s2, 1, lane);
      if (hh == 0) {
        unsigned long long pk = ((unsigned long long)__float_as_uint(s2) << 32) | (unsigned long long)__float_as_uint(s1);
        __hip_atomic_store(stats + (size_t)(brow + rr) * 4 + pn, pk, __ATOMIC_RELAXED, __HIP_MEMORY_SCOPE_AGENT);
      }
    }
    asm volatile("s_waitcnt vmcnt(0)" ::: "memory");
    __syncthreads();
    if (tid_ == 0) {
      __hip_atomic_fetch_add(cnt, 1u, __ATOMIC_RELAXED, __HIP_MEMORY_SCOPE_AGENT);
      const unsigned target = 4u * (unsigned)(l * 3 + lnidx + 1);
      unsigned sp = 0;
      while (__hip_atomic_load(cnt, __ATOMIC_RELAXED, __HIP_MEMORY_SCOPE_AGENT) < target) {
        __builtin_amdgcn_s_sleep(1);
        if (++sp > (1u << 24)) break;
      }
    }
    __syncthreads();
    if (tid_ < 384 && hh == 0) {
      float s1 = 0.f, s2 = 0.f;
#pragma unroll
      for (int q = 0; q < 4; ++q) {
        unsigned long long pk = __hip_atomic_load(stats + (size_t)(brow + rr) * 4 + q, __ATOMIC_RELAXED, __HIP_MEMORY_SCOPE_AGENT);
        s1 += __uint_as_float((unsigned)(pk & 0xffffffffull));
        s2 += __uint_as_float((unsigned)(pk >> 32));
      }
      const float mu = s1 * (1.f / 1024.f);
      const float var = fmaxf(s2 * (1.f / 1024.f) - mu * mu, 0.f);
      float2 st;
      st.x = mu;
      st.y = rsqrtf(var + 1e-5f);
      *(float2*)(lsm + 25600 + rr * 2) = st;
    }
    __syncthreads();
    int row0b = row0, colb = col, rl0b = rl0;
    asm volatile("" : "+v"(row0b), "+v"(colb), "+v"(rl0b));
    const bool last = (lnidx == 2) && (l == NLAYER - 1);
    const float4 lg = *(const float4*)(p.ln_g + (size_t)(l * 3 + lnidx) * 1024 + colb);
    const float4 lb = *(const float4*)(p.ln_b + (size_t)(l * 3 + lnidx) * 1024 + colb);
    const int ml = (lnidx == 2) ? l + 1 : l;
    const int sidx = (lnidx == 0) ? 3 : (lnidx == 1 ? 6 : 0);
    float* xdst = last ? p.out : xres;
    u16* hdst = (u16*)(ws + OFF_H);
    float4 sh_lo, sc_lo, sh_hi, sc_hi;
    if (!last) {
      const float* mlo = modb + ((size_t)(ml * 5 + ci_lo) * 9 + sidx) * 1024 + colb;
      const float* mhi = modb + ((size_t)(ml * 5 + ci_hi) * 9 + sidx) * 1024 + colb;
      sh_lo = *(const float4*)mlo; sc_lo = *(const float4*)(mlo + 1024);
      sh_hi = *(const float4*)mhi; sc_hi = *(const float4*)(mhi + 1024);
    }
    {
      int rowv = row0b;
#pragma unroll
      for (int m = 0; m < MT; ++m) {
        asm volatile("" : "+v"(rowv));
#pragma unroll
        for (int j = 0; j < 4; ++j) {
          const int row = rowv + j;
          const float2 st = *(const float2*)(lsm + 25600 + (rl0b + m * 16 + j) * 2);
          float4 x;
          x.x = (acc[m][0][j] - st.x) * st.y * lg.x + lb.x;
          x.y = (acc[m][1][j] - st.x) * st.y * lg.y + lb.y;
          x.z = (acc[m][2][j] - st.x) * st.y * lg.z + lb.z;
          x.w = (acc[m][3][j] - st.x) * st.y * lg.w + lb.w;
          *(float4*)(xdst + (size_t)row * 1024 + colb) = x;
          if (!last) {
            const bool lo = cond_index(row) == ci_lo;
            uint2 o;
            o.x = pack2(x.x * (1.f + (lo ? sc_lo.x : sc_hi.x)) + (lo ? sh_lo.x : sh_hi.x),
                        x.y * (1.f + (lo ? sc_lo.y : sc_hi.y)) + (lo ? sh_lo.y : sh_hi.y));
            o.y = pack2(x.z * (1.f + (lo ? sc_lo.z : sc_hi.z)) + (lo ? sh_lo.z : sh_hi.z),
                        x.w * (1.f + (lo ? sc_lo.w : sc_hi.w)) + (lo ? sh_lo.w : sh_hi.w));
            *(uint2*)(hdst + (size_t)row * 1024 + colb) = o;
          }
        }
        rowv += 16;
        SCHED();
      }
    }
  } else if constexpr (kind == K_IN) {
    if (pn < 3) {
      float* proj = (float*)(ws + OFF_V) + (size_t)row0 * PROJ_W + bcol + wc * 64 + fr * 4;
#pragma unroll
      for (int m = 0; m < MT; ++m) {
#pragma unroll
        for (int j = 0; j < 4; ++j) {
          float4 o;
          o.x = acc[m][0][j]; o.y = acc[m][1][j]; o.z = acc[m][2][j]; o.w = acc[m][3][j];
          *(float4*)(proj + (size_t)(m * 16 + j) * PROJ_W) = o;
        }
        SCHED();
      }
    } else {
      u16* uxg = (u16*)(ws + OFF_XCF) + (size_t)row0 * 1024 + (bcol - 768) + wc * 64 + fr * 4;
#pragma unroll
      for (int m = 0; m < MT; ++m) {
#pragma unroll
        for (int j = 0; j < 4; ++j) {
          uint2 o;
          o.x = pack2(acc[m][0][j], acc[m][1][j]);
          o.y = pack2(acc[m][2][j], acc[m][3][j]);
          *(uint2*)(uxg + (size_t)(m * 16 + j) * 1024) = o;
        }
        SCHED();
      }
    }
  } else if constexpr (kind == K_Q) {
    const float* rope = (const float*)(ws + OFF_ROPE);
#pragma unroll
    for (int g2 = 0; g2 < 2; ++g2) {
      const int cb = bcol + wc * 64 + g2 * 32;
      const bool is_rope = (brow >= NCTX) && ((cb % 96) == 64);
      u16* q = (u16*)(ws + OFF_Q) + (size_t)row0 * 768 + cb + fr;
#pragma unroll
      for (int m = 0; m < MT; ++m) {
#pragma unroll
        for (int j = 0; j < 4; ++j) {
          float x1 = acc[m][2 * g2][j], x2 = acc[m][2 * g2 + 1][j];
          if (is_rope) {
            int t = (row0 + m * 16 + j - NCTX) & 1023;
            float cs = rope[t * 32 + fr], sn = rope[t * 32 + 16 + fr];
            float o1 = x1 * cs - x2 * sn, o2 = x1 * sn + x2 * cs;
            x1 = o1;
            x2 = o2;
          }
          q[(m * 16 + j) * 768] = f2bf(x1 * QSCALE);
          q[(m * 16 + j) * 768 + 16] = f2bf(x2 * QSCALE);
        }
        SCHED();
      }
    }
  } else if constexpr (kind == K_KV) {
    size_t vbase;
    int key0, Tk;
    if (brow < NCTX) {
      int b = brow >> 8;
      vbase = (size_t)b * 512 * 256;
      key0 = 0;
      Tk = 256;
    } else {
      int rr = brow - NCTX;
      int b = rr / 1280;
      key0 = rr - b * 1280;
      vbase = (size_t)NCTX * 512 + (size_t)b * 512 * 1280;
      Tk = 1280;
    }
    const int h = pn * 2 + (wc >> 1);
    if ((wc & 1) == 0) {
      u16* kn = (u16*)(ws + OFF_KN) + (size_t)row0 * 512 + h * 64 + fr;
#pragma unroll
      for (int m = 0; m < MT; ++m) {
#pragma unroll
        for (int j = 0; j < 4; ++j)
#pragma unroll
          for (int n = 0; n < 4; ++n) kn[(m * 16 + j) * 512 + n * 16] = f2bf(acc[m][n][j]);
        SCHED();
      }
    } else {
      u16* vt = (u16*)(ws + OFF_VT) + vbase + (size_t)(h * 64 + fr) * Tk + key0 + wr * 128 + fq * 4;
#pragma unroll
      for (int m = 0; m < MT; ++m) {
#pragma unroll
        for (int n = 0; n < 4; ++n) {
          uint2 pk;
          pk.x = pack2(acc[m][n][0], acc[m][n][1]);
          pk.y = pack2(acc[m][n][2], acc[m][n][3]);
          *(uint2*)(vt + (size_t)(n * 16) * Tk + m * 16) = pk;
        }
        SCHED();
      }
    }
  } else if constexpr (kind == K_GATE) {
    const int ch = pn * 64 + wc * 16 + fr;
    const size_t o0 = (size_t)row0 * 512 + ch;
    uint2* au = (uint2*)(ws + OFF_ACT) + o0;
    const u16* xcb = (const u16*)(ws + OFF_XC) + o0;
    float ba[2], bx[2], sp[2];
#pragma unroll
    for (int d = 0; d < 2; ++d) {
      const int pidx = (l * 2 + d) * 512 + ch;
      ba[d] = p.lru_b_a[pidx];
      bx[d] = p.lru_b_x[pidx];
      sp[d] = -8.f * log1pf(__expf(-p.lru_lambda[pidx]));
    }
#pragma unroll
    for (int m = 0; m < MT; ++m) {
#pragma unroll
      for (int j = 0; j < 4; ++j) {
        const int idx = (m * 16 + j) * 512;
        const float xv = __uint_as_float((unsigned)xcb[idx] << 16);
        unsigned w[2];
#pragma unroll
        for (int d = 0; d < 2; ++d) {
          float rg = sigmoid_f(acc[m][d * 2][j] + ba[d]);
          float ig = sigmoid_f(acc[m][d * 2 + 1][j] + bx[d]);
          float la = rg * sp[d];
          unsigned q = (unsigned)fminf(-la * 32768.f + 0.5f, 65535.f);
          float a = __expf(-(float)q * (1.f / 32768.f));
          float mult = __builtin_amdgcn_sqrtf(fmaxf(1.f - a * a, 0.f));
          w[d] = (pack2(0.f, mult * ig * xv) & 0xffff0000u) | q;
        }
        uint2 o;
        o.x = w[0];
        o.y = w[1];
        au[idx] = o;
      }
      SCHED();
    }
  }
}

DEVI void tile_map(int Lp, int nM, int nN, int& pm, int& pn) {
  int nig = 8 * nN, gid = Lp / nig, fm = gid * 8, gsz = min(nM - fm, 8);
  int w = Lp % nig;
  pm = fm + w % gsz;
  pn = w / gsz;
}

template <int kind, int MT>
DEVI void gemm_phase(int wv_, const P& p, const u16* A, const u16* B, int lda, int ldb, int K, int nM, int nN, int l, int sub, int rot) {
  const int G = gridDim.x, bid = blockIdx.x;
  const int total = nM * nN;
  const int per = G >> 3;
  int idx = (bid & 7) * per + (bid >> 3) + rot;
  if (idx >= G) idx -= G;
  int L = idx;
  if (L >= total) return;
  int pm, pn;
  tile_map(L, nM, nN, pm, pn);
  const u16* Ap = A;
  const u16* Bp = B;
  int bcol = pn * 256;
  if constexpr (kind == K_GATE) {
    Ap = A + pn * 64;
    Bp = B + (size_t)pn * 256 * 64;
    bcol = 0;
  }
  gemm_stage0<MT>(wv_, Ap, lda, Bp, ldb, pm * (MT * 32), bcol);
  for (;;) {
    f32x4 acc[MT][4];
    if constexpr (MT == 6) gemm_core_pipe<MT>(wv_, Ap, lda, Bp, ldb, K, pm * (MT * 32), bcol, acc);
    else gemm_core<MT>(wv_, Ap, lda, Bp, ldb, K, pm * (MT * 32), bcol, acc);
    const int cpm = pm, cpn = pn;
    L += G;
    const bool more = L < total;
    if (more) {
      tile_map(L, nM, nN, pm, pn);
      Ap = A;
      Bp = B;
      bcol = pn * 256;
      if constexpr (kind == K_GATE) {
        Ap = A + pn * 64;
        Bp = B + (size_t)pn * 256 * 64;
        bcol = 0;
      }
      gemm_stage0<MT>(wv_, Ap, lda, Bp, ldb, pm * (MT * 32), bcol);
    }
    gemm_epilogue<kind, MT>(wv_, p, l, sub, cpm, cpn, acc);
    if (!more) break;
  }
  __syncthreads();
}

constexpr int CONV_TILES = 5064;
DEVI void convert_layer_tiles(int wv_, const P& p, int layer, int first, int last, int wslot, int nslots) {
  char* ws = p.ws;
  const int tid = get_tid(wv_);
  const int wid = tid >> 6, lane = tid & 63;
  u16* tl = shm + wid * (64 * 72);
  const int nq = lane & 15, kr = lane >> 4;
  for (int ti = first + wslot; ti < last; ti += nslots) {
    const float* src;
    u16* dst;
    int K, Nsrc, Np, job, local, mat;
    if (ti < 2816) { job = 0; mat = layer * 2 + (ti >= 1408); local = ti % 1408; K = 1024; Nsrc = 5632; Np = 5632; }
    else if (ti < 4224) { job = 1; mat = layer * 2 + (ti >= 3520); local = (ti - 2816) % 704; K = 2816; Nsrc = 1024; Np = 1024; }
    else if (ti < 4672) { job = 2; mat = layer; local = ti - 4224; K = 1024; Nsrc = 1696; Np = 1792; }
    else if (ti < 4744) { job = 3; mat = layer; local = ti - 4672; K = 384; Nsrc = 768; Np = 768; }
    else if (ti < 4808) { job = 4; mat = layer; local = ti - 4744; K = 256; Nsrc = 1024; Np = 1024; }
    else { job = 5; mat = layer; local = ti - 4808; K = 1024; Nsrc = 1024; Np = 1024; }
    int kt = local / (Np / 64), nt = local % (Np / 64);
    switch (job) {
      case 0: src = p.w_up; dst = (u16*)(ws + OFF_WUP); break;
      case 1: src = p.w_down; dst = (u16*)(ws + OFF_WDN); break;
      case 2: src = p.w_in; dst = (u16*)(ws + OFF_WIN); break;
      case 3: src = p.w_uq; dst = (u16*)(ws + OFF_WUQ); break;
      case 4: src = p.w_ukv; dst = (u16*)(ws + OFF_WUKV); break;
      default: src = p.w_o; dst = (u16*)(ws + OFF_WO); break;
    }
    src += (size_t)mat * K * Nsrc;
    dst += (size_t)mat * Np * K;
    const int np = nt * 64 + nq * 4;
    int sc;
    if (job == 0) {
      int j = np >> 8, w = np & 255, wcg = w >> 6, x = w & 63;
      sc = x < 32 ? j * 128 + wcg * 32 + x : 2816 + j * 128 + wcg * 32 + (x - 32);
    } else if (job == 2) {
      sc = np < 672 ? np : (np < 768 ? -1 : np - 96);
    } else sc = np;
    const float* sp = src + (size_t)(kt * 64 + kr * 4) * Nsrc + (sc >= 0 ? sc : 0);
    float4 r[4][4];
#pragma unroll
    for (int kb = 0; kb < 4; ++kb)
#pragma unroll
      for (int e = 0; e < 4; ++e) {
        float4 v = *(const float4*)(sp + (size_t)(kb * 16 + e) * Nsrc);
        if (sc < 0) v = float4{0.f, 0.f, 0.f, 0.f};
        r[kb][e] = v;
      }
    int lr0 = nq * 4, lr1 = nq * 4 + 1, lr2 = nq * 4 + 2, lr3 = nq * 4 + 3;
    if (job == 0) {
      const int hb = (nq >> 3) * 32, s0 = (nq & 7) * 4;
      lr0 = hb + (s0 >> 1);
      lr1 = hb + 16 + (s0 >> 1);
      lr2 = hb + (s0 >> 1) + 1;
      lr3 = hb + 16 + (s0 >> 1) + 1;
    } else if (job == 1 || job == 2 || job == 5) {
      lr0 = nq; lr1 = 16 + nq; lr2 = 32 + nq; lr3 = 48 + nq;
    }
#pragma unroll
    for (int kb = 0; kb < 4; ++kb) {
      const int k = kb * 16 + kr * 4;
      uint2 o;
      o.x = pack2(r[kb][0].x, r[kb][1].x); o.y = pack2(r[kb][2].x, r[kb][3].x);
      *(uint2*)(tl + lr0 * 72 + k) = o;
      o.x = pack2(r[kb][0].y, r[kb][1].y); o.y = pack2(r[kb][2].y, r[kb][3].y);
      *(uint2*)(tl + lr1 * 72 + k) = o;
      o.x = pack2(r[kb][0].z, r[kb][1].z); o.y = pack2(r[kb][2].z, r[kb][3].z);
      *(uint2*)(tl + lr2 * 72 + k) = o;
      o.x = pack2(r[kb][0].w, r[kb][1].w); o.y = pack2(r[kb][2].w, r[kb][3].w);
      *(uint2*)(tl + lr3 * 72 + k) = o;
    }
    asm volatile("s_waitcnt lgkmcnt(0)" ::: "memory");
    {
      const int seg = lane & 7, nr = lane >> 3;
#pragma unroll
      for (int j = 0; j < 8; ++j) {
        int n = j * 8 + nr;
        uint4 v = *(const uint4*)(tl + n * 72 + seg * 8);
        *(uint4*)(dst + (size_t)(nt * 64 + n) * K + kt * 64 + seg * 8) = v;
      }
    }
    asm volatile("s_waitcnt lgkmcnt(0)" ::: "memory");
  }
  __syncthreads();
}

DEVI void mod_layer(int wv_, const P& p, int l, int first, int stride) {
  const int tid = get_tid(wv_);
  char* ws = p.ws;
  float* sf = (float*)shm;
  float* scond = sf;
  float* red = sf + 5 * 1024;
  for (int i = tid; i < 5 * 1024; i += 512) {
    int ci = i >> 10, k = i & 1023;
    float cv = ci == 0 ? p.c_ctx[k] : p.c[(ci - 1) * 1024 + k];
    scond[i] = silu_f(cv);
  }
  __syncthreads();
  const int cgp = tid & 15, ks = tid >> 4;
  for (int ch = first; ch < 144; ch += stride) {
    const int col0 = ch * 64;
    float a[5][4];
#pragma unroll
    for (int ci = 0; ci < 5; ++ci)
#pragma unroll
      for (int e = 0; e < 4; ++e) a[ci][e] = 0.f;
    const float* wp = p.w_mod + ((size_t)l * 1024 + ks * 32) * 9216 + col0 + cgp * 4;
#pragma unroll 8
    for (int kk = 0; kk < 32; ++kk) {
      float4 w = *(const float4*)(wp + (size_t)kk * 9216);
      int k = ks * 32 + kk;
#pragma unroll
      for (int ci = 0; ci < 5; ++ci) {
        float s = scond[ci * 1024 + k];
        a[ci][0] += s * w.x;
        a[ci][1] += s * w.y;
        a[ci][2] += s * w.z;
        a[ci][3] += s * w.w;
      }
    }
#pragma unroll
    for (int ci = 0; ci < 5; ++ci)
#pragma unroll
      for (int e = 0; e < 4; ++e) red[(ks * 5 + ci) * 64 + cgp * 4 + e] = a[ci][e];
    __syncthreads();
    if (tid < 320) {
      int ci = tid >> 6, cc = tid & 63;
      float s = 0.f;
      for (int k2 = 0; k2 < 32; ++k2) s += red[(k2 * 5 + ci) * 64 + cc];
      s += p.b_mod[(size_t)l * 9216 + col0 + cc];
      ((float*)(ws + OFF_MOD))[((size_t)l * 5 + ci) * 9216 + col0 + cc] = s;
    }
    __syncthreads();
  }
}

DEVI void prep_phase(int wv_, const P& p) {
  const int G = gridDim.x, bid = blockIdx.x, tid = get_tid(wv_);
  char* ws = p.ws;
  float* sf = (float*)shm;
  for (int ml = 0; ml < NLAYER; ++ml) mod_layer(wv_, p, ml, (bid + ml * 112) % G, G);
  convert_layer_tiles(wv_, p, 0, 0, CONV_TILES, bid * 8 + (tid >> 6), G * 8);
  {
    u16* wg = (u16*)(ws + OFF_WG);
    const int total = 4 * 8 * 256 * 64;
    for (int i = bid * 512 + tid; i < total; i += G * 512) {
      int k = i & 63, row = (i >> 6) & 255, nb = (i >> 14) & 7, l = i >> 17;
      int wcg = row >> 6, n = (row >> 4) & 3, fr = row & 15;
      int dir = n >> 1, gt = n & 1, e = wcg * 16 + fr;
      const float* w = gt == 0 ? p.lru_w_a : p.lru_w_x;
      wg[i] = f2bf(w[((((size_t)l * 2 + dir) * 8 + nb) * 64 + k) * 64 + e]);
    }
  }
  {
    float* rope = (float*)(ws + OFF_ROPE);
    for (int i = bid * 512 + tid; i < 1024 * 16; i += G * 512) {
      int t = i >> 4, f = i & 15;
      float pos = (f < 8) ? (float)(t >> 6) : (float)(t & 63);
      float inv = powf(10000.f, -(float)(f & 7) / 8.f);
      float ang = pos * inv;
      rope[t * 32 + f] = cosf(ang);
      rope[t * 32 + 16 + f] = sinf(ang);
    }
  }
}

DEVI void ln_phase(int wv_, const P& p, bool do_ln, int lnl, int lnidx, bool write_h, int ml, int shift_idx, bool final_out) {
  const int G = gridDim.x, bid = blockIdx.x, tid_ = get_tid(wv_), wid = tid_ >> 6, lane = tid_ & 63;
  char* ws = p.ws;
  const float* v = (const float*)(ws + OFF_V);
  float* xres = (float*)(ws + OFF_XRES);
  u16* h = (u16*)(ws + OFF_H);
  const float* modb = (const float*)(ws + OFF_MOD);
  for (int row = (bid * 8 + wid); row < NTOK; row += G * 8) {
    float4 x[4];
    if (do_ln) {
      const float4* vr = (const float4*)(v + (size_t)row * 1024);
      float s = 0.f;
#pragma unroll
      for (int i = 0; i < 4; ++i) {
        x[i] = vr[lane + 64 * i];
        s += x[i].x + x[i].y + x[i].z + x[i].w;
      }
      float mu = wave_sum(s, lane) * (1.f / 1024.f);
      float s2 = 0.f;
#pragma unroll
      for (int i = 0; i < 4; ++i) {
        x[i].x -= mu; x[i].y -= mu; x[i].z -= mu; x[i].w -= mu;
        s2 += x[i].x * x[i].x + x[i].y * x[i].y + x[i].z * x[i].z + x[i].w * x[i].w;
      }
      float rstd = rsqrtf(wave_sum(s2, lane) * (1.f / 1024.f) + 1e-5f);
      const float4* gp = (const float4*)(p.ln_g + (size_t)(lnl * 3 + lnidx) * 1024);
      const float4* bp = (const float4*)(p.ln_b + (size_t)(lnl * 3 + lnidx) * 1024);
      float4* dst = final_out ? (float4*)(p.out + (size_t)row * 1024) : (float4*)(xres + (size_t)row * 1024);
#pragma unroll
      for (int i = 0; i < 4; ++i) {
        float4 g = gp[lane + 64 * i], b = bp[lane + 64 * i];
        x[i].x = x[i].x * rstd * g.x + b.x;
        x[i].y = x[i].y * rstd * g.y + b.y;
        x[i].z = x[i].z * rstd * g.z + b.z;
        x[i].w = x[i].w * rstd * g.w + b.w;
        dst[lane + 64 * i] = x[i];
      }
    } else {
      const float4* xr = (const float4*)(row < NCTX ? p.x_prompt + (size_t)row * 1024 : p.x_sample + (size_t)(row - NCTX) * 1024);
#pragma unroll
      for (int i = 0; i < 4; ++i) x[i] = xr[lane + 64 * i];
    }
    if (write_h) {
      const int ci = cond_index(row);
      const float4* sh = (const float4*)(modb + ((size_t)(ml * 5 + ci) * 9 + shift_idx) * 1024);
      const float4* sc = (const float4*)(modb + ((size_t)(ml * 5 + ci) * 9 + shift_idx + 1) * 1024);
      uint2* hd = (uint2*)(h + (size_t)row * 1024);
#pragma unroll
      for (int i = 0; i < 4; ++i) {
        float4 a = sh[lane + 64 * i], b = sc[lane + 64 * i];
        uint2 o;
        o.x = pack2(x[i].x * (1.f + b.x) + a.x, x[i].y * (1.f + b.y) + a.y);
        o.y = pack2(x[i].z * (1.f + b.z) + a.z, x[i].w * (1.f + b.w) + a.w);
        hd[lane + 64 * i] = o;
      }
    }
  }
}

DEVI void post_phase(int wv_, const P& p, int l) {
  const int G = gridDim.x, bid = blockIdx.x, tid_ = get_tid(wv_), wid = tid_ >> 6, lane = tid_ & 63;
  char* ws = p.ws;
  const float* proj = (const float*)(ws + OFF_V);
  u16* cqn = (u16*)(ws + OFF_CQN);
  u16* ckvn = (u16*)(ws + OFF_CKVN);
  u16* kr = (u16*)(ws + OFF_KR);
  u16* xc = (u16*)(ws + OFF_XC);
  const float* rope = (const float*)(ws + OFF_ROPE);
  const u16* uxg = (const u16*)(ws + OFF_XCF);
  float4 cw[2][4], cbias[2];
#pragma unroll
  for (int i = 0; i < 2; ++i) {
    const int ch = lane * 4 + 256 * i;
    cbias[i] = *(const float4*)(p.conv_b + l * 512 + ch);
#pragma unroll
    for (int k = 0; k < 4; ++k) cw[i][k] = *(const float4*)(p.conv_w + (size_t)(l * 4 + k) * 512 + ch);
  }
  float gq[6];
#pragma unroll
  for (int i = 0; i < 6; ++i) gq[i] = p.qg[l * 384 + lane + 64 * i];
  const float4 gkv = *(const float4*)(p.kvg + l * 256 + lane * 4);
  const int l15 = lane & 15;
  for (int r0 = bid * 8 + wid; r0 < NTOK; r0 += 2 * G * 8) {
    float cq[2][6];
    float4 cv[2], xv[2][2][4];
    float x1[2], x2[2], rcs[2], rsn[2];
    int tt[2], TT[2], bb[2];
    bool ctx[2], ok[2];
#pragma unroll
    for (int q = 0; q < 2; ++q) {
      const int r = r0 + q * G * 8;
      ok[q] = r < NTOK;
      const int rc = ok[q] ? r : r0;
      ctx[q] = rc < NCTX;
      if (ctx[q]) { bb[q] = rc >> 8; tt[q] = rc & 255; TT[q] = 256; }
      else { int rr = rc - NCTX; bb[q] = rr >> 10; tt[q] = rr & 1023; TT[q] = 1024; }
      const float* pr = proj + (size_t)rc * PROJ_W;
#pragma unroll
      for (int i = 0; i < 6; ++i) cq[q][i] = pr[lane + 64 * i];
      cv[q] = *(const float4*)(pr + 384 + lane * 4);
      x1[q] = pr[640 + l15];
      x2[q] = pr[656 + l15];
      rcs[q] = rope[(tt[q] & 1023) * 32 + l15];
      rsn[q] = rope[(tt[q] & 1023) * 32 + 16 + l15];
#pragma unroll
      for (int i = 0; i < 2; ++i)
#pragma unroll
        for (int k = 0; k < 4; ++k) {
          const int t2 = tt[q] - 2 + k;
          const bool v = (t2 >= 0) && (t2 < TT[q]);
          const uint2 raw = *(const uint2*)(uxg + ((size_t)rc + (v ? k - 2 : 0)) * 1024 + lane * 4 + 256 * i);
          float4 f;
          f.x = __uint_as_float(raw.x << 16); f.y = __uint_as_float(raw.x & 0xffff0000u);
          f.z = __uint_as_float(raw.y << 16); f.w = __uint_as_float(raw.y & 0xffff0000u);
          xv[q][i][k] = v ? f : float4{0.f, 0.f, 0.f, 0.f};
        }
    }
#pragma unroll
    for (int q = 0; q < 2; ++q) {
      if (!ok[q]) continue;
      const int r = r0 + q * G * 8;
      const int b = bb[q], t = tt[q];
      const size_t rowp = ctx[q] ? (size_t)r : (size_t)NCTX + b * 1280 + 256 + t;
      {
        float ss = 0.f;
#pragma unroll
        for (int i = 0; i < 6; ++i) ss += cq[q][i] * cq[q][i];
        const float rstd = rsqrtf(wave_sum(ss, lane) * (1.f / 384.f) + 1e-6f);
#pragma unroll
        for (int i = 0; i < 6; ++i) cqn[(size_t)r * 384 + lane + 64 * i] = f2bf(cq[q][i] * rstd * gq[i]);
      }
      {
        float4 c4 = cv[q];
        float ss = c4.x * c4.x + c4.y * c4.y + c4.z * c4.z + c4.w * c4.w;
        const float rstd = rsqrtf(wave_sum(ss, lane) * (1.f / 256.f) + 1e-6f);
        c4.x *= rstd * gkv.x; c4.y *= rstd * gkv.y; c4.z *= rstd * gkv.z; c4.w *= rstd * gkv.w;
        if (ctx[q]) *(float4*)(p.out + OUT_CKV + ((size_t)(b * 4 + l) * 256 + t) * 256 + lane * 4) = c4;
        uint2 o;
        o.x = pack2(c4.x, c4.y);
        o.y = pack2(c4.z, c4.w);
        *(uint2*)(ckvn + rowp * 256 + lane * 4) = o;
      }
      if (lane < 16) {
        float a1 = x1[q], a2 = x2[q];
        if (ctx[q]) {
          float* okp = p.out + OUT_KROPE + ((size_t)(b * 4 + l) * 256 + t) * 32;
          okp[lane] = a1;
          okp[16 + lane] = a2;
        } else {
          const float o1 = a1 * rcs[q] - a2 * rsn[q], o2 = a1 * rsn[q] + a2 * rcs[q];
          a1 = o1;
          a2 = o2;
        }
        kr[rowp * 32 + lane] = f2bf(a1);
        kr[rowp * 32 + 16 + lane] = f2bf(a2);
      }
#pragma unroll
      for (int i = 0; i < 2; ++i) {
        const int ch = lane * 4 + 256 * i;
        float4 av = cbias[i];
#pragma unroll
        for (int k = 0; k < 4; ++k) {
          av.x += xv[q][i][k].x * cw[i][k].x;
          av.y += xv[q][i][k].y * cw[i][k].y;
          av.z += xv[q][i][k].z * cw[i][k].z;
          av.w += xv[q][i][k].w * cw[i][k].w;
        }
        uint2 o;
        o.x = pack2(av.x, av.y);
        o.y = pack2(av.z, av.w);
        *(uint2*)(xc + (size_t)r * 512 + ch) = o;
      }
    }
  }
  for (int idx = bid * 8 + wid; idx < 1024; idx += G * 8) {
    const int b = idx >> 8, pp = idx & 255;
    const size_t rowp = (size_t)NCTX + b * 1280 + pp;
    const float4 c4 = *(const float4*)(p.cache_ckv + ((size_t)(b * 4 + l) * 256 + pp) * 256 + lane * 4);
    uint2 o;
    o.x = pack2(c4.x, c4.y);
    o.y = pack2(c4.z, c4.w);
    *(uint2*)(ckvn + rowp * 256 + lane * 4) = o;
    if (lane < 32) kr[rowp * 32 + lane] = f2bf(p.cache_krope[((size_t)(b * 4 + l) * 256 + pp) * 32 + lane]);
  }
}

constexpr int KS_STRIDE = 104;
constexpr int VS_STRIDE = 72;
constexpr int KS_ELEMS = 64 * KS_STRIDE, VS_ELEMS = 64 * VS_STRIDE;

DEVI void attn_item(int wv_, const P& p, int item) {
  const int tid = get_tid(wv_), wid = tid >> 6, lane = tid & 63, fr = lane & 15, fq = lane >> 4;
  char* ws = p.ws;
  const u16* q = (const u16*)(ws + OFF_Q);
  const u16* kn = (const u16*)(ws + OFF_KN);
  const u16* kr = (const u16*)(ws + OFF_KR);
  const u16* vt = (const u16*)(ws + OFF_VT);
  u16* mix = (u16*)(ws + OFF_MIX);
  int h, r0, rowp0, Tk;
  size_t vbase;
  if (item < 128) {
    int b = item >> 5, qb = item & 3;
    h = (item >> 2) & 7;
    r0 = NCTX + b * 1024 + qb * 256;
    rowp0 = NCTX + b * 1280;
    Tk = 1280;
    vbase = (size_t)NCTX * 512 + (size_t)b * 512 * 1280 + (size_t)h * 64 * 1280;
  } else {
    int it = item - 128, b = it >> 3;
    h = it & 7;
    r0 = b * 256;
    rowp0 = b * 256;
    Tk = 256;
    vbase = (size_t)b * 512 * 256 + (size_t)h * 64 * 256;
  }
  u16* Ks = shm;
  u16* Vs = shm + 2 * KS_ELEMS;
  bf16x8 qf[2][3];
#pragma unroll
  for (int nb = 0; nb < 2; ++nb)
#pragma unroll
    for (int ks = 0; ks < 3; ++ks)
      qf[nb][ks] = *(const bf16x8*)(q + (size_t)(r0 + wid * 32 + nb * 16 + fr) * 768 + h * 96 + ks * 32 + fq * 8);
  f32x4 o[4][2];
#pragma unroll
  for (int db = 0; db < 4; ++db)
#pragma unroll
    for (int nb = 0; nb < 2; ++nb) o[db][nb] = f32x4{0.f, 0.f, 0.f, 0.f};
  float mrun[2] = {-INFINITY, -INFINITY}, lrun[2] = {0.f, 0.f};
  const int ntile = Tk >> 6;
  uint4 gk, gv, gr;
  const int skey = tid >> 3, sseg = tid & 7;
  const int rkey = tid >> 2, rseg = tid & 3;
  auto gload = [&](int kt) {
    int k0 = kt * 64;
    gk = *(const uint4*)(kn + (size_t)(rowp0 + k0 + skey) * 512 + h * 64 + sseg * 8);
    gv = *(const uint4*)(vt + vbase + (size_t)skey * Tk + k0 + sseg * 8);
    if (tid < 256) gr = *(const uint4*)(kr + (size_t)(rowp0 + k0 + rkey) * 32 + rseg * 8);
  };
  auto lstore = [&](int buf) {
    *(uint4*)(Ks + buf * KS_ELEMS + skey * KS_STRIDE + sseg * 8) = gk;
    *(uint4*)(Vs + buf * VS_ELEMS + skey * VS_STRIDE + sseg * 8) = gv;
    if (tid < 256) *(uint4*)(Ks + buf * KS_ELEMS + rkey * KS_STRIDE + 64 + rseg * 8) = gr;
  };
  gload(0);
  lstore(0);
  __syncthreads();
  for (int kt = 0; kt < ntile; ++kt) {
    const int buf = kt & 1;
    if (kt + 1 < ntile) gload(kt + 1);
    const u16* Kb = Ks + buf * KS_ELEMS;
    const u16* Vb = Vs + buf * VS_ELEMS;
    f32x4 s[4][2];
#pragma unroll
    for (int kb = 0; kb < 4; ++kb) {
      s[kb][0] = f32x4{0.f, 0.f, 0.f, 0.f};
      s[kb][1] = f32x4{0.f, 0.f, 0.f, 0.f};
#pragma unroll
      for (int ks = 0; ks < 3; ++ks) {
        bf16x8 kf = *(const bf16x8*)(Kb + (kb * 16 + fr) * KS_STRIDE + ks * 32 + fq * 8);
        s[kb][0] = __builtin_amdgcn_mfma_f32_16x16x32_bf16(kf, qf[0][ks], s[kb][0], 0, 0, 0);
        s[kb][1] = __builtin_amdgcn_mfma_f32_16x16x32_bf16(kf, qf[1][ks], s[kb][1], 0, 0, 0);
      }
    }
    bf16x8 pf[2][2];
#pragma unroll
    for (int nb = 0; nb < 2; ++nb) {
      float mx = s[0][nb][0];
#pragma unroll
      for (int kb = 0; kb < 4; ++kb)
#pragma unroll
        for (int j = 0; j < 4; ++j) mx = fmaxf(mx, s[kb][nb][j]);
      mx = rows_max(mx);
      float mnew = fmaxf(mrun[nb], mx);
      float alpha = __builtin_amdgcn_exp2f(mrun[nb] - mnew);
      mrun[nb] = mnew;
      float ls = 0.f;
#pragma unroll
      for (int kb = 0; kb < 4; ++kb)
#pragma unroll
        for (int j = 0; j < 4; ++j) {
          float pv = __builtin_amdgcn_exp2f(s[kb][nb][j] - mnew);
          s[kb][nb][j] = pv;
          ls += pv;
        }
      lrun[nb] = lrun[nb] * alpha + ls;
#pragma unroll
      for (int db = 0; db < 4; ++db) {
        o[db][nb][0] *= alpha; o[db][nb][1] *= alpha; o[db][nb][2] *= alpha; o[db][nb][3] *= alpha;
      }
#pragma unroll
      for (int pp = 0; pp < 2; ++pp) {
        union { bf16x8 v; unsigned u[4]; } cv;
        cv.u[0] = pack2(s[2 * pp][nb][0], s[2 * pp][nb][1]);
        cv.u[1] = pack2(s[2 * pp][nb][2], s[2 * pp][nb][3]);
        cv.u[2] = pack2(s[2 * pp + 1][nb][0], s[2 * pp + 1][nb][1]);
        cv.u[3] = pack2(s[2 * pp + 1][nb][2], s[2 * pp + 1][nb][3]);
        pf[pp][nb] = cv.v;
      }
    }
#pragma unroll
    for (int db = 0; db < 4; ++db)
#pragma unroll
      for (int pp = 0; pp < 2; ++pp) {
        union { bf16x8 v; uint2 u[2]; } vf;
        vf.u[0] = *(const uint2*)(Vb + (db * 16 + fr) * VS_STRIDE + 32 * pp + fq * 4);
        vf.u[1] = *(const uint2*)(Vb + (db * 16 + fr) * VS_STRIDE + 32 * pp + 16 + fq * 4);
        o[db][0] = __builtin_amdgcn_mfma_f32_16x16x32_bf16(vf.v, pf[pp][0], o[db][0], 0, 0, 0);
        o[db][1] = __builtin_amdgcn_mfma_f32_16x16x32_bf16(vf.v, pf[pp][1], o[db][1], 0, 0, 0);
      }
    if (kt + 1 < ntile) lstore(buf ^ 1);
    __syncthreads();
  }
#pragma unroll
  for (int nb = 0; nb < 2; ++nb) {
    float lt = lrun[nb];
    lt = rows_sum(lt);
    float inv = 1.f / lt;
    int row = r0 + wid * 32 + nb * 16 + fr;
#pragma unroll
    for (int db = 0; db < 4; ++db) {
      uint2 pk;
      pk.x = pack2(o[db][nb][0] * inv, o[db][nb][1] * inv);
      pk.y = pack2(o[db][nb][2] * inv, o[db][nb][3] * inv);
      *(uint2*)(mix + (size_t)row * 1024 + h * 64 + db * 16 + fq * 4) = pk;
    }
  }
}

template <int LC, int CHB>
DEVI void scan_item_t(int wv_, const P& p, int l, int b, int cgi, int r0, bool is_ctx) {
  constexpr int CH = 1 << CHB, NCH = 256 / CH;
  const int tid = get_tid(wv_), c = tid & (CH - 1), dir = (tid >> CHB) & 1, k = tid >> (CHB + 1);
  char* ws = p.ws;
  const int ch = cgi * CH + c;
  const int t0 = k * LC;
  const int kk = dir ? NCH - 1 - k : k;
  const unsigned* ap = (const unsigned*)(ws + OFF_ACT) + ((size_t)(r0 + t0) * 512 + ch) * 2 + dir;
  const u16* ugp = (const u16*)(ws + OFF_XCF) + (size_t)(r0 + t0) * 1024 + 512 + ch;
  const int stride = dir ? -1024 : 1024;
  const int start = dir ? (LC - 1) * 1024 : 0;
  float a[LC], u[LC], ug[LC / 2];
#pragma unroll
  for (int i = 0; i < LC; ++i) {
    const unsigned t = ap[start + i * stride];
    a[i] = __expf(-(float)(t & 0xffffu) * (1.f / 32768.f));
    u[i] = __uint_as_float(t & 0xffff0000u);
  }
#pragma unroll
  for (int i = 0; i < LC; i += 2) ug[i / 2] = __uint_as_float((unsigned)ugp[(dir ? LC - 1 - i : i) * 1024] << 16);
  float* sm = (float*)shm;
  {
    float A = 1.f, H = 0.f;
#pragma unroll
    for (int i = 0; i < LC; ++i) {
      H = a[i] * H + u[i];
      A *= a[i];
    }
    sm[(dir * NCH + kk) * CH + c] = A;
    sm[512 + (dir * NCH + kk) * CH + c] = H;
  }
  __syncthreads();
  float h = is_ctx ? 0.f : p.state_lru[((size_t)(b * 4 + l) * 2 + dir) * 512 + ch];
  for (int j = 0; j < kk; ++j) h = sm[(dir * NCH + j) * CH + c] * h + sm[512 + (dir * NCH + j) * CH + c];
#pragma unroll
  for (int i = 0; i < LC; ++i) {
    h = a[i] * h + u[i];
    u[i] = h;
  }
  if (is_ctx && kk == NCH - 1) p.out[OUT_STATE + ((size_t)(b * 4 + l) * 2 + dir) * 512 + ch] = h;
  u16* mix = (u16*)(ws + OFF_MIX) + (size_t)(r0 + t0) * 1024 + 512 + ch;
  const int lane = tid & 63;
#pragma unroll
  for (int i = 0; i < LC; i += 2) {
    float other = shfl_xor_f(u[LC - 1 - i], CH, lane);
    float sum = u[i] + other;
    int t = dir ? LC - 1 - i : i;
    mix[(size_t)t * 1024] = f2bf(sum * gelu_tanh(ug[i / 2]));
  }
  __syncthreads();
}

DEVI void scan_item(int wv_, const P& p, int l, int si) {
  if (si < 128) {
    int b = si >> 5, cgi = si & 31;
    scan_item_t<64, 4>(wv_, p, l, b, cgi, NCTX + b * 1024, false);
  } else {
    int it = si - 128, b = it >> 4, cgi = it & 15;
    scan_item_t<32, 5>(wv_, p, l, b, cgi, b * 256, true);
  }
}

DEVI void mixer_phase(int wv_, const P& p, int l) {
  const int G = gridDim.x, bid = blockIdx.x;
  if (G == 256) {
    if (bid < 128) {
      attn_item(wv_, p, bid);
      __syncthreads();
    } else {
      attn_item(wv_, p, 128 + (bid - 128));
      __syncthreads();
      attn_item(wv_, p, 256 + (bid - 128));
      __syncthreads();
      scan_item(wv_, p, l, bid - 128);
      for (int k = 0; k < 4; ++k) scan_item(wv_, p, l, 128 + k * 128 + (bid - 128));
    }
  } else {
    for (int it = bid; it < 384 + 640; it += G) {
      if (it < 384) attn_item(wv_, p, it);
      else scan_item(wv_, p, l, it - 384);
      __syncthreads();
    }
  }
}

#define XB_TMO      128
#define XB_XCNT(j)  (256  + 64 * (j))
#define XB_XSUB(j)  (1280 + 64 * (j))
#define XB_XGEN(j)  (2304 + 64 * (j))
#define XB_TOP      3328
#define XB_TOPGEN   3392
#define XCD_BAR_WORDS 3456
#define XB_SPIN_CAP (1u << 22)
#define LAS __attribute__((address_space(3)))
DEVI unsigned xb_ld(unsigned* p) { return __hip_atomic_load(p, __ATOMIC_RELAXED, __HIP_MEMORY_SCOPE_AGENT); }
DEVI unsigned xb_add(unsigned* p, unsigned v) { return __hip_atomic_fetch_add(p, v, __ATOMIC_RELAXED, __HIP_MEMORY_SCOPE_AGENT); }
DEVI unsigned xb_xcc_id() { return (unsigned)__builtin_amdgcn_s_getreg((3 << 11) | 20) & 0xFu; }
#define XB_SPIN(cond, bar) do { unsigned _sp = 0; while (cond) { __builtin_amdgcn_s_sleep(1); \
    if ((++_sp & 255u) == 0u) { if (xb_ld(&(bar)[XB_TMO])) break; if (_sp > XB_SPIN_CAP) { atomicAdd(&(bar)[XB_TMO], 1u); break; } } } } while (0)
struct XcdBarrier { unsigned* bar; unsigned x; volatile LAS unsigned* st; };
DEVI XcdBarrier xcd_barrier_post(unsigned* bar, volatile LAS unsigned* st) {
  XcdBarrier b; b.bar = bar; b.x = xb_xcc_id(); b.st = st;
  if (threadIdx.x == 0) (void)xb_add(&bar[XB_XCNT(b.x)], 1u);
  return b;
}
DEVI void xcd_barrier_complete(unsigned* bar, unsigned x, unsigned& nloc, unsigned& nx) {
  const unsigned G = gridDim.x * gridDim.y * gridDim.z;
  unsigned sum, cnt, mine, sp = 0u;
  for (;;) {
    sum = 0u; cnt = 0u; mine = 0u;
#pragma unroll
    for (unsigned j = 0; j < 16; ++j) { const unsigned c = xb_ld(&bar[XB_XCNT(j)]); sum += c; cnt += (c > 0u) ? 1u : 0u; mine = (j == x) ? c : mine; }
    if (sum == G) break;
    __builtin_amdgcn_s_sleep(1);
    if ((++sp & 255u) == 0u) { if (xb_ld(&bar[XB_TMO])) break; if (sp > XB_SPIN_CAP) { atomicAdd(&bar[XB_TMO], 1u); break; } }
  }
  nloc = mine > 0u ? mine : 1u; nx = cnt > 0u ? cnt : 1u;
}
DEVI void xcd_barrier(const XcdBarrier& b, int wv_) {
  asm volatile("s_waitcnt vmcnt(0)" ::: "memory");
  __syncthreads();
  if (get_tid(wv_) == 0) {
    unsigned* bar = b.bar;
    __builtin_amdgcn_s_waitcnt(0);
    unsigned nloc = b.st[0], nx = b.st[1];
    if (nloc == 0u) { xcd_barrier_complete(bar, b.x, nloc, nx); b.st[0] = nloc; b.st[1] = nx; }
    const unsigned old = xb_add(&bar[XB_XSUB(b.x)], 1u);
    const unsigned gen = old / nloc;
    if (old + 1u == (gen + 1u) * nloc) {
      __builtin_amdgcn_fence(__ATOMIC_RELEASE, "agent");
      asm volatile("s_waitcnt vmcnt(0)" ::: "memory");
      const unsigned og = xb_add(&bar[XB_TOP], 1u);
      const unsigned tg = og / nx;
      if (og + 1u == (tg + 1u) * nx) xb_add(&bar[XB_TOPGEN], 1u);
      else XB_SPIN(xb_ld(&bar[XB_TOPGEN]) == tg, bar);
      __builtin_amdgcn_fence(__ATOMIC_ACQUIRE, "agent");
      xb_add(&bar[XB_XGEN(b.x)], 1u);
      asm volatile("s_waitcnt vmcnt(0)" ::: "memory");
    } else {
      XB_SPIN(xb_ld(&bar[XB_XGEN(b.x)]) == gen, bar);
      __builtin_amdgcn_fence(__ATOMIC_ACQUIRE, "agent");
      asm volatile("s_waitcnt vmcnt(0)" ::: "memory");
    }
  }
  __syncthreads();
}

__global__ void __launch_bounds__(512) fwd_megakernel(P p) {
  cg::grid_group grid = cg::this_grid();
  const int wv_ = __builtin_amdgcn_readfirstlane((int)threadIdx.x >> 6);
  char* ws = p.ws;
  volatile LAS unsigned* xbst = (volatile LAS unsigned*)&shm[65536];
  if (threadIdx.x < 4) xbst[threadIdx.x] = 0u;
  __syncthreads();
  const XcdBarrier xb = xcd_barrier_post((unsigned*)(ws + OFF_BAR), xbst);
  const u16* hbuf = (const u16*)(ws + OFF_H);
  const int NPH = 2 + 9 * NLAYER;
  for (int ph = 0; ph < NPH; ++ph) {
    if (ph == 0) {
      prep_phase(wv_, p);
    } else if (ph == 1) {
      ln_phase(wv_, p, false, 0, 0, true, 0, 0, false);
    } else {
      const int l = (ph - 2) / 9, s = (ph - 2) % 9;
      if (s == 0 || s == 7) {
        const int sub = (s == 7);
        gemm_phase<K_UP, 6>(wv_, p, hbuf, (const u16*)(ws + OFF_WUP) + (size_t)(l * 2 + sub) * 5632 * 1024, 1024, 1024, 1024, 64, 22, l, sub, 0);
        if (l + 1 < NLAYER) {
          const int bid = blockIdx.x, slot = (bid & 7) * (gridDim.x >> 3) + (bid >> 3);
          if (slot >= 128)
            convert_layer_tiles(wv_, p, l + 1, sub ? CONV_TILES / 2 : 0, sub ? CONV_TILES : CONV_TILES / 2, (slot - 128) * 8 + wv_, 1024);
        }
      } else if (s == 1 || s == 8) {
        const int sub = (s == 8);
        gemm_phase<K_DOWN, 6>(wv_, p, (const u16*)(ws + OFF_ACT), (const u16*)(ws + OFF_WDN) + (size_t)(l * 2 + sub) * 1024 * 2816, 2816, 2816, 2816, 64, 4, l, sub, 0);
      } else if (s == 2) {
        gemm_phase<K_IN, 6>(wv_, p, hbuf, (const u16*)(ws + OFF_WIN) + (size_t)l * 1792 * 1024, 1024, 1024, 1024, 64, 7, l, 0, 0);
      } else if (s == 3) {
        post_phase(wv_, p, l);
      } else if (s == 4) {
        gemm_phase<K_GATE, 8>(wv_, p, (const u16*)(ws + OFF_XC), (const u16*)(ws + OFF_WG) + (size_t)l * 8 * 256 * 64, 512, 64, 64, 48, 8, l, 0, 0);
        gemm_phase<K_KV, 8>(wv_, p, (const u16*)(ws + OFF_CKVN), (const u16*)(ws + OFF_WUKV) + (size_t)l * 1024 * 256, 256, 256, 256, 52, 4, l, 0, 128);
        gemm_phase<K_Q, 8>(wv_, p, (const u16*)(ws + OFF_CQN), (const u16*)(ws + OFF_WUQ) + (size_t)l * 768 * 384, 384, 384, 384, 48, 3, l, 0, 176);
      } else if (s == 5) {
        mixer_phase(wv_, p, l);
      } else if (s == 6) {
        gemm_phase<K_O, 6>(wv_, p, (const u16*)(ws + OFF_MIX), (const u16*)(ws + OFF_WO) + (size_t)l * 1024 * 1024, 1024, 1024, 1024, 64, 4, l, 0, 0);
      }
    }
    if (ph == 0) grid.sync();
    else if (ph + 1 < NPH) xcd_barrier(xb, wv_);
  }
}

extern "C" void kernel_launch(void* const* d_in, const int* in_sizes, int n_in, void* d_out, int out_size, void* d_ws,
                              size_t ws_size, hipStream_t stream) {
  constexpr size_t kDynLds = 131072 + 16;
  static int grid_blocks = 0;
  if (!grid_blocks) {
    hipFuncSetAttribute((const void*)fwd_megakernel, hipFuncAttributeMaxDynamicSharedMemorySize, (int)kDynLds);
    int dev = 0, cus = 0, per_cu = 0;
    hipGetDevice(&dev);
    hipDeviceGetAttribute(&cus, hipDeviceAttributeMultiprocessorCount, dev);
    hipOccupancyMaxActiveBlocksPerMultiprocessor(&per_cu, fwd_megakernel, 512, kDynLds);
    if (per_cu < 1) per_cu = 1;
    if (per_cu > 1) per_cu = 1;
    grid_blocks = cus * per_cu;
    grid_blocks &= ~7;
    if (grid_blocks != 256) fprintf(stderr, "unexpected grid %d (fused LN epilogue assumes 256)\n", grid_blocks);
    if (ws_size < WS_NEED) fprintf(stderr, "workspace too small: %zu < %zu\n", ws_size, (size_t)WS_NEED);
  }
  P p{};
  const float** pp = (const float**)&p;
  for (int i = 0; i < 26; ++i) pp[i] = (const float*)d_in[i];
  p.out = (float*)d_out;
  p.ws = (char*)d_ws;
  hipMemsetAsync((char*)d_ws + OFF_BAR, 0, 16384, stream);
  void* args[] = {&p};
  hipError_t e = hipLaunchCooperativeKernel((const void*)fwd_megakernel, dim3(grid_blocks), dim3(512), args, kDynLds, stream);
  if (e != hipSuccess) fprintf(stderr, "cooperative launch failed: %s (grid %d)\n", hipGetErrorString(e), grid_blocks);
}
```

```cpp
#include <hip/hip_runtime.h>
#include <hip/hip_bf16.h>
#include <hip/hip_cooperative_groups.h>
#include <cstdio>
namespace cg = cooperative_groups;

typedef unsigned short u16;
using bf16x8 = __attribute__((ext_vector_type(8))) short;
using f32x4 = __attribute__((ext_vector_type(4))) float;
#define DEVI __device__ __forceinline__

constexpr int D = 1024, NTOK = 12288, NCTX = 8192, DFF = 2816, NLAYER = 4;
constexpr int NKV = 13312;
constexpr int PROJ_W = 1792;
constexpr float ALPHA_F = 1.681792830507429f;
constexpr float QSCALE = 0.10206207261596577f * 1.4426950408889634f;

constexpr size_t al256(size_t x) { return (x + 255) & ~(size_t)255; }
constexpr size_t OFF_MOD = 0;
constexpr size_t OFF_ROPE = OFF_MOD + al256((size_t)4 * 5 * 9216 * 4);
constexpr size_t OFF_WUP = OFF_ROPE + al256((size_t)1024 * 32 * 4);
constexpr size_t OFF_WDN = OFF_WUP + (size_t)8 * 5632 * 1024 * 2;
constexpr size_t OFF_WIN = OFF_WDN + (size_t)8 * 1024 * 2816 * 2;
constexpr size_t OFF_WUQ = OFF_WIN + (size_t)4 * 1792 * 1024 * 2;
constexpr size_t OFF_WUKV = OFF_WUQ + (size_t)4 * 768 * 384 * 2;
constexpr size_t OFF_WG = OFF_WUKV + (size_t)4 * 1024 * 256 * 2;
constexpr size_t OFF_WO = OFF_WG + (size_t)4 * 8 * 256 * 256 * 2;
constexpr size_t OFF_XRES = OFF_WO + (size_t)4 * 1024 * 1024 * 2;
constexpr size_t OFF_H = OFF_XRES + (size_t)NTOK * 1024 * 4;
constexpr size_t OFF_ACT = OFF_H + (size_t)NTOK * 1024 * 2;
constexpr size_t OFF_V = OFF_ACT + (size_t)4 * NTOK * 512 * 4;
constexpr size_t OFF_CQN = OFF_V + (size_t)NTOK * PROJ_W * 4;
constexpr size_t OFF_CKVN = OFF_CQN + (size_t)NTOK * 384 * 2;
constexpr size_t OFF_KR = OFF_CKVN + (size_t)NKV * 256 * 2;
constexpr size_t OFF_XC = OFF_KR + (size_t)NKV * 32 * 2;
constexpr size_t OFF_XCF = OFF_XC + (size_t)NTOK * 512 * 2;
constexpr size_t OFF_Q = OFF_XCF + (size_t)NTOK * 512 * 4;
constexpr size_t OFF_KN = OFF_Q + (size_t)NTOK * 768 * 2;
constexpr size_t OFF_VT = OFF_KN + (size_t)NKV * 512 * 2;
constexpr size_t OFF_MIX = OFF_VT + (size_t)NKV * 512 * 2;
constexpr size_t OFF_HF = OFF_MIX + (size_t)NTOK * 1024 * 2;
constexpr size_t OFF_BAR = OFF_HF + (size_t)NTOK * 512 * 4;
constexpr size_t OFF_STATS = OFF_BAR + 16384;
constexpr size_t WS_NEED = OFF_STATS + (size_t)NTOK * 4 * 8;
constexpr int LNCNT_WORD = 3520;

constexpr size_t OUT_CKV = 12582912, OUT_KROPE = 20971520, OUT_STATE = 22020096;

struct P {
  const float *x_prompt, *x_sample, *cache_ckv, *cache_krope, *state_lru, *c, *c_ctx, *w_mod, *b_mod, *ln_g, *ln_b,
      *w_up, *w_down, *w_in, *qg, *kvg, *w_uq, *w_ukv, *conv_w, *conv_b, *lru_w_a, *lru_b_a, *lru_w_x, *lru_b_x,
      *lru_lambda, *w_o;
  float* out;
  char* ws;
};

extern __shared__ __attribute__((aligned(16))) u16 shm[];

typedef __bf16 bf16x2_t __attribute__((ext_vector_type(2)));
typedef float f32x2_t __attribute__((ext_vector_type(2)));
DEVI unsigned pack2(float a, float b) {
  f32x2_t v = {a, b};
  bf16x2_t r = __builtin_convertvector(v, bf16x2_t);
  return *(unsigned*)&r;
}
DEVI u16 f2bf(float f) { return (u16)(pack2(f, 0.f) & 0xffffu); }
DEVI float sigmoid_f(float x) { return __builtin_amdgcn_rcpf(1.f + __expf(-x)); }
DEVI float silu_f(float x) { return x * __builtin_amdgcn_rcpf(1.f + __expf(-x)); }
DEVI float gelu_tanh(float x) {
  float y = 0.7978845608028654f * (x + 0.044715f * x * x * x);
  float t = 1.f - 2.f * __builtin_amdgcn_rcpf(1.f + __expf(2.f * y));
  return 0.5f * x * (1.f + t);
}
DEVI int lane_asm() {
  int l;
  asm volatile("v_mbcnt_lo_u32_b32 %0, -1, 0\n\tv_mbcnt_hi_u32_b32 %0, -1, %0" : "=v"(l));
  return l;
}
DEVI int get_tid(int wv_) { return wv_ * 64 + lane_asm(); }
DEVI float shfl_xor_f(float v, int o, int lane) {
  return __int_as_float(__builtin_amdgcn_ds_bpermute((lane ^ o) << 2, __float_as_int(v)));
}
DEVI float wave_sum(float v, int lane) {
#pragma unroll
  for (int o = 32; o > 0; o >>= 1) v += shfl_xor_f(v, o, lane);
  return v;
}
DEVI int cond_index(int r) { return r < NCTX ? 0 : 1 + ((r - NCTX) >> 10); }

constexpr int BK = 64, TILE_B = 256 * BK * 2, STAGE_B = 2 * TILE_B;

DEVI int lds_byte(int r, int c) {
  int st = (r >> 4) * 2 + (c >> 5), ob = (r & 15) * 64 + (c & 31) * 2;
  return st * 1024 + (ob ^ (((ob >> 9) & 1) << 5));
}
DEVI void stage_rc(int b, int& R, int& C) {
  int st = b >> 10, sb = b & 1023, swz = sb ^ (((sb >> 9) & 1) << 5);
  R = (st >> 1) * 16 + swz / 64;
  C = (st & 1) * 32 + (swz % 64) / 2;
}
#define WAIT_V(n) asm volatile("s_waitcnt vmcnt(%0)" ::"n"(n) : "memory")
#define SCHED() __builtin_amdgcn_sched_barrier(0)

template <int MT>
DEVI void gemm_stage0(int wv_, const u16* __restrict__ A, int lda, const u16* __restrict__ Bt, int ldb, int brow, int bcol) {
  char* sm = (char*)shm;
  const int tid = get_tid(wv_), wid = tid >> 6, lane = tid & 63;
  const u16* Ab = A + (long)brow * lda;
  const u16* Bb = Bt + (long)bcol * ldb;
#pragma unroll
  for (int i = 0; i < 4; ++i) {
    int r, c;
    stage_rc(wid * 1024 + i * 8192 + lane * 16, r, c);
    if (i < MT / 2)
      __builtin_amdgcn_global_load_lds((const unsigned*)(Ab + (long)r * lda + c),
                                       (unsigned*)(sm + wid * 1024 + i * 8192), 16, 0, 0);
    __builtin_amdgcn_global_load_lds((const unsigned*)(Bb + (long)r * ldb + c),
                                     (unsigned*)(sm + TILE_B + wid * 1024 + i * 8192), 16, 0, 0);
  }
}

template <int MT>
DEVI void gemm_core(int wv_, const u16* __restrict__ A, int lda, const u16* __restrict__ Bt, int ldb, int K, int brow,
                    int bcol, f32x4 (&acc)[MT][4]) {
  char* sm = (char*)shm;
  const int tid = get_tid(wv_), wid = tid >> 6, lane = tid & 63, wr = wid >> 2, wc = wid & 3, fr = lane & 15,
            fq = lane >> 4;
  const u16* Ab = A + (long)brow * lda;
  const u16* Bb = Bt + (long)bcol * ldb;
  long offA[MT / 2], offB[4];
#pragma unroll
  for (int i = 0; i < 4; ++i) {
    int r, c;
    stage_rc(wid * 1024 + i * 8192 + lane * 16, r, c);
    if (i < MT / 2) offA[i] = (long)r * lda + c;
    offB[i] = (long)r * ldb + c;
  }
#define GLDS_STAGE(buf, kt)                                                                                  \
  do {                                                                                                       \
    _Pragma("unroll") for (int i = 0; i < 4; ++i) {                                                          \
      if (i < MT / 2)                                                                                        \
        __builtin_amdgcn_global_load_lds((const unsigned*)(Ab + offA[i] + (kt)*BK),                          \
                                         (unsigned*)(sm + (buf)*STAGE_B + wid * 1024 + i * 8192), 16, 0, 0); \
      __builtin_amdgcn_global_load_lds((const unsigned*)(Bb + offB[i] + (kt)*BK),                            \
                                       (unsigned*)(sm + (buf)*STAGE_B + TILE_B + wid * 1024 + i * 8192), 16, 0, 0); \
    }                                                                                                        \
  } while (0)
#pragma unroll
  for (int m = 0; m < MT; ++m)
#pragma unroll
    for (int n = 0; n < 4; ++n) acc[m][n] = f32x4{0.f, 0.f, 0.f, 0.f};
  const int nt = K / BK;
  WAIT_V(0);
  __syncthreads();
  for (int t = 0; t < nt; ++t) {
    const int cur = t & 1;
    if (t + 1 < nt) GLDS_STAGE(cur ^ 1, t + 1);
#pragma unroll
    for (int ks = 0; ks < 2; ++ks) {
      bf16x8 At[MT], Bf[4];
#pragma unroll
      for (int m = 0; m < MT; ++m)
        At[m] = *(const bf16x8*)(sm + cur * STAGE_B + lds_byte(wr * (MT * 16) + m * 16 + fr, ks * 32 + fq * 8));
#pragma unroll
      for (int n = 0; n < 4; ++n)
        Bf[n] = *(const bf16x8*)(sm + cur * STAGE_B + TILE_B + lds_byte(wc * 64 + n * 16 + fr, ks * 32 + fq * 8));
#pragma unroll
      for (int m = 0; m < MT; ++m)
#pragma unroll
        for (int n = 0; n < 4; ++n)
          acc[m][n] = __builtin_amdgcn_mfma_f32_16x16x32_bf16(At[m], Bf[n], acc[m][n], 0, 0, 0);
      SCHED();
    }
    WAIT_V(0);
    __syncthreads();
  }
}

template <int MT>
DEVI void gemm_core_pipe(int wv_, const u16* __restrict__ A, int lda, const u16* __restrict__ Bt, int ldb, int K,
                         int brow, int bcol, f32x4 (&acc)[MT][4]) {
  char* sm = (char*)shm;
  const int tid = get_tid(wv_), wid = tid >> 6, lane = tid & 63, wr = wid >> 2, wc = wid & 3, fr = lane & 15,
            fq = lane >> 4;
  const u16* Ab = A + (long)brow * lda;
  const u16* Bb = Bt + (long)bcol * ldb;
  long offA[MT / 2], offB[4];
#pragma unroll
  for (int i = 0; i < 4; ++i) {
    int r, c;
    stage_rc(wid * 1024 + i * 8192 + lane * 16, r, c);
    if (i < MT / 2) offA[i] = (long)r * lda + c;
    offB[i] = (long)r * ldb + c;
  }
  const int a_off = lds_byte(wr * (MT * 16) + fr, fq * 8);
  const int b_off = TILE_B + lds_byte(wc * 64 + fr, fq * 8);
#define RFRAG(Fa, Fb, buf, ks)                                                                              \
  do {                                                                                                      \
    _Pragma("unroll") for (int m = 0; m < MT; ++m)                                                          \
      Fa[m] = *(const bf16x8*)(sm + (buf)*STAGE_B + a_off + m * 2048 + (ks)*1024);                         \
    _Pragma("unroll") for (int n = 0; n < 4; ++n)                                                           \
      Fb[n] = *(const bf16x8*)(sm + (buf)*STAGE_B + b_off + n * 2048 + (ks)*1024);                         \
  } while (0)
#define MMAS(Fa, Fb)                                                                                        \
  do {                                                                                                      \
    _Pragma("unroll") for (int m = 0; m < MT; ++m)                                                          \
      _Pragma("unroll") for (int n = 0; n < 4; ++n)                                                         \
        acc[m][n] = __builtin_amdgcn_mfma_f32_16x16x32_bf16(Fa[m], Fb[n], acc[m][n], 0, 0, 0);             \
  } while (0)
#pragma unroll
  for (int m = 0; m < MT; ++m)
#pragma unroll
    for (int n = 0; n < 4; ++n) acc[m][n] = f32x4{0.f, 0.f, 0.f, 0.f};
  const int nt = K / BK;
  bf16x8 A0[MT], B0[4], A1[MT], B1[4];
  WAIT_V(0);
  __syncthreads();
  if (nt > 1) GLDS_STAGE(1, 1);
  RFRAG(A0, B0, 0, 0);
  SCHED();
  for (int t = 0; t < nt; ++t) {
    const int cur = t & 1;
    RFRAG(A1, B1, cur, 1);
    SCHED();
    MMAS(A0, B0);
    SCHED();
    asm volatile("s_waitcnt lgkmcnt(0)" ::: "memory");
    WAIT_V(0);
    __syncthreads();
    if (t + 1 < nt) RFRAG(A0, B0, cur ^ 1, 0);
    SCHED();
    if (t + 2 < nt) GLDS_STAGE(cur, t + 2);
    MMAS(A1, B1);
    _Pragma("unroll") for (int g = 0; g < MT / 2 + 4; ++g) {
      __builtin_amdgcn_sched_group_barrier(0x008, 3, 0);
      __builtin_amdgcn_sched_group_barrier(0x006, 6, 0);
      __builtin_amdgcn_sched_group_barrier(0x020, 1, 0);
    }
    __builtin_amdgcn_sched_group_barrier(0x008, MT * 4 - 3 * (MT / 2 + 4), 0);
    SCHED();
  }
#undef RFRAG
#undef MMAS
}

constexpr int P8_AH = 96 * 64 * 2, P8_BH = 128 * 64 * 2;
DEVI void gemm_core_8p(int wv_, const u16* __restrict__ A, int lda, const u16* __restrict__ Bt, int ldb, int K, int brow,
                       int bcol, f32x4 (&acc)[6][4]) {
  char* sm = (char*)shm;
  const int tid = get_tid(wv_), wid = tid >> 6, lane = tid & 63, wr = wid >> 2, wc = wid & 3, fr = lane & 15,
            fq = lane >> 4;
  const u16* Ab = A + (long)brow * lda;
  const u16* Bb = Bt + (long)bcol * ldb;
  int oA[2][2], oB[2][2];
#pragma unroll
  for (int i = 0; i < 2; ++i) {
    int r, c;
    stage_rc(tid * 16 + i * 8192, r, c);
    {
      const int w4 = r >> 5, n1 = (r >> 4) & 1, f = r & 15;
      oB[0][i] = (w4 * 64 + (0 * 2 + n1) * 16 + f) * ldb + c;
      oB[1][i] = (w4 * 64 + (1 * 2 + n1) * 16 + f) * ldb + c;
    }
    {
      const int rr = r < 96 ? r : 0;
      const int w2 = rr >= 48 ? 1 : 0, rem = rr - w2 * 48, m3 = rem >> 4, f = rem & 15;
      oA[0][i] = (w2 * 96 + (0 * 3 + m3) * 16 + f) * lda + c;
      oA[1][i] = (w2 * 96 + (1 * 3 + m3) * 16 + f) * lda + c;
    }
  }
  const bool a2 = tid < 256;
#define P8_SA(b, h) (sm + ((b)*2 + (h)) * P8_AH)
#define P8_SB(b, h) (sm + 4 * P8_AH + ((b)*2 + (h)) * P8_BH)
#define P8_STA(b, h, kt)                                                                                    \
  do {                                                                                                      \
    __builtin_amdgcn_global_load_lds((const unsigned*)(Ab + oA[h][0] + (long)(kt)*BK),                      \
                                     (unsigned*)(P8_SA(b, h) + tid * 16), 16, 0, 0);                        \
    if (a2)                                                                                                 \
      __builtin_amdgcn_global_load_lds((const unsigned*)(Ab + oA[h][1] + (long)(kt)*BK),                    \
                                       (unsigned*)(P8_SA(b, h) + tid * 16 + 8192), 16, 0, 0);               \
  } while (0)
#define P8_STB(b, h, kt)                                                                                    \
  do {                                                                                                      \
    __builtin_amdgcn_global_load_lds((const unsigned*)(Bb + oB[h][0] + (long)(kt)*BK),                      \
                                     (unsigned*)(P8_SB(b, h) + tid * 16), 16, 0, 0);                        \
    __builtin_amdgcn_global_load_lds((const unsigned*)(Bb + oB[h][1] + (long)(kt)*BK),                      \
                                     (unsigned*)(P8_SB(b, h) + tid * 16 + 8192), 16, 0, 0);                 \
  } while (0)
#define P8_LDA(dst, b, h)                                                                                   \
  _Pragma("unroll") for (int m = 0; m < 3; ++m) _Pragma("unroll") for (int k = 0; k < 2; ++k)               \
      dst[m][k] = *(const bf16x8*)(P8_SA(b, h) + lds_byte(wr * 48 + m * 16 + fr, k * 32 + fq * 8))
#define P8_LDB(dst, b, h)                                                                                   \
  _Pragma("unroll") for (int n = 0; n < 2; ++n) _Pragma("unroll") for (int k = 0; k < 2; ++k)               \
      dst[n][k] = *(const bf16x8*)(P8_SB(b, h) + lds_byte(wc * 32 + n * 16 + fr, k * 32 + fq * 8))
#define P8_MMA(ai, bj, At_, Bt_)                                                                            \
  do {                                                                                                      \
    __builtin_amdgcn_s_setprio(1);                                                                          \
    _Pragma("unroll") for (int m = 0; m < 3; ++m) _Pragma("unroll") for (int n = 0; n < 2; ++n)             \
        _Pragma("unroll") for (int k = 0; k < 2; ++k) acc[(ai)*3 + m][(bj)*2 + n] =                         \
            __builtin_amdgcn_mfma_f32_16x16x32_bf16(At_[m][k], Bt_[n][k], acc[(ai)*3 + m][(bj)*2 + n], 0, 0, 0); \
    __builtin_amdgcn_s_setprio(0);                                                                          \
  } while (0)
#define P8_WL(n) asm volatile("s_waitcnt lgkmcnt(%0)" ::"n"(n) : "memory")
#define P8_BAR __builtin_amdgcn_s_barrier()
#pragma unroll
  for (int m = 0; m < 6; ++m)
#pragma unroll
    for (int n = 0; n < 4; ++n) acc[m][n] = f32x4{0.f, 0.f, 0.f, 0.f};
  bf16x8 At[3][2], B0[2][2], B1[2][2];
  const int nt = K / BK;
  __syncthreads();
  P8_STB(0, 0, 0); P8_STA(0, 0, 0); P8_STB(0, 1, 0); P8_STA(0, 1, 0);
  if (wr == 1) P8_BAR;
  WAIT_V(3); P8_BAR;
  P8_STB(1, 0, 1); P8_STA(1, 0, 1); P8_STB(1, 1, 1);
  WAIT_V(5); P8_BAR;
  for (int t = 0; t < nt - 2; t += 2) {
    P8_LDB(B0, 0, 0); SCHED(); P8_LDA(At, 0, 0); P8_STA(1, 1, t + 1);
    P8_WL(6); P8_BAR; P8_WL(0); P8_MMA(0, 0, At, B0); P8_BAR; SCHED();
    P8_LDB(B1, 0, 1); P8_STB(0, 0, t + 2);
    P8_BAR; P8_WL(0); P8_MMA(0, 1, At, B1); P8_BAR;
    P8_LDA(At, 0, 1); P8_STA(0, 0, t + 2);
    P8_BAR; P8_WL(0); P8_MMA(1, 0, At, B0); P8_BAR; SCHED();
    P8_STB(0, 1, t + 2);
    WAIT_V(5); P8_BAR; P8_MMA(1, 1, At, B1); P8_BAR;
    P8_LDB(B0, 1, 0); SCHED(); P8_LDA(At, 1, 0); P8_STA(0, 1, t + 2);
    P8_WL(6); P8_BAR; P8_WL(0); P8_MMA(0, 0, At, B0); P8_BAR; SCHED();
    P8_LDB(B1, 1, 1); P8_STB(1, 0, t + 3);
    P8_BAR; P8_WL(0); P8_MMA(0, 1, At, B1); P8_BAR;
    P8_LDA(At, 1, 1); P8_STA(1, 0, t + 3);
    P8_BAR; P8_WL(0); P8_MMA(1, 0, At, B0); P8_BAR; SCHED();
    P8_STB(1, 1, t + 3);
    WAIT_V(5); P8_BAR; P8_MMA(1, 1, At, B1); P8_BAR;
  }
  {
    P8_LDB(B0, 0, 0); P8_LDA(At, 0, 0); P8_STA(1, 1, nt - 1);
    P8_BAR; P8_WL(0); P8_MMA(0, 0, At, B0); P8_BAR;
    P8_LDB(B1, 0, 1); P8_BAR; P8_WL(0); P8_MMA(0, 1, At, B1); P8_BAR;
    P8_LDA(At, 0, 1); WAIT_V(3); P8_BAR; P8_WL(0); P8_MMA(1, 0, At, B0); P8_MMA(1, 1, At, B1); P8_BAR;
  }
  {
    P8_LDB(B0, 1, 0); P8_LDA(At, 1, 0); WAIT_V(1); P8_BAR; P8_WL(0); P8_MMA(0, 0, At, B0); P8_BAR;
    P8_LDB(B1, 1, 1); WAIT_V(0); P8_BAR; P8_WL(0); P8_MMA(0, 1, At, B1); P8_BAR;
    P8_LDA(At, 1, 1); P8_BAR; P8_WL(0); P8_MMA(1, 0, At, B0); P8_MMA(1, 1, At, B1); P8_BAR;
  }
  if (wr == 0) P8_BAR;
}

enum { K_UP = 0, K_DOWN = 1, K_IN = 2, K_Q = 3, K_KV = 4, K_GATE = 5, K_O = 6 };

struct GemmDesc {
  const u16* A;
  const u16* B;
  int lda, ldb, K, nM, nN, kind;
};

template <int kind, int MT>
DEVI void gemm_epilogue(int wv_, const P& p, int l, int sub, int pm, int pn, f32x4 (&acc)[MT][4]) {
  const int tid_ = get_tid(wv_), wid = tid_ >> 6, lane = tid_ & 63, wr = wid >> 2, wc = wid & 3, fr = lane & 15,
            fq = lane >> 4;
  char* ws = p.ws;
  const int brow = pm * (MT * 32), bcol = pn * 256;
  const int row0 = brow + wr * (MT * 16) + fq * 4;
  if constexpr (kind == K_UP) {
    u16* act = (u16*)(ws + OFF_ACT) + (size_t)row0 * DFF + pn * 128 + wc * 32 + fr * 2;
#pragma unroll
    for (int m = 0; m < MT; ++m) {
#pragma unroll
      for (int j = 0; j < 4; ++j) {
        float v0 = silu_f(acc[m][0][j]) * acc[m][2][j];
        float v1 = silu_f(acc[m][1][j]) * acc[m][3][j];
        *(unsigned*)(act + (size_t)(m * 16 + j) * DFF) = pack2(v0, v1);
      }
      SCHED();
    }
  } else if constexpr (kind == K_DOWN || kind == K_O) {
    static_assert(MT == 6, "fused LN epilogue assumes 192-row tiles");
    const int gidx = (kind == K_O) ? 5 : (sub == 0 ? 2 : 8);
    const int lnidx = (kind == K_O) ? 1 : (sub == 0 ? 0 : 2);
    const float gs = (kind == K_O) ? 1.f : 0.5f;
    const int col = bcol + wc * 64 + fr * 4;
    const float* modb = (const float*)(ws + OFF_MOD);
    float* xres = (float*)(ws + OFF_XRES);
    float* lsm = (float*)shm;
    const int rl0 = wr * 96 + fq * 4;
    const bool first_in = (kind == K_DOWN) && (l == 0) && (sub == 0);
    const float* xin_lo = p.x_prompt;
    const float* xin_hi = p.x_sample - (size_t)NCTX * 1024;
#define XSRC(row) (first_in ? ((row) < NCTX ? xin_lo : xin_hi) : (const float*)xres)
    const int ci_lo = cond_index(brow), ci_hi = cond_index(brow + 191);
    const float4 gt_lo = *(const float4*)(modb + ((size_t)(l * 5 + ci_lo) * 9 + gidx) * 1024 + col);
    const float4 gt_hi = *(const float4*)(modb + ((size_t)(l * 5 + ci_hi) * 9 + gidx) * 1024 + col);
    {
      float4 xa[4], xb[4];
      int rowv = row0;
      asm volatile("" : "+v"(rowv));
#pragma unroll
      for (int j = 0; j < 4; ++j) xa[j] = *(const float4*)(XSRC(rowv + j) + (size_t)(rowv + j) * 1024 + col);
#pragma unroll
      for (int m = 0; m < MT; ++m) {
        const int rowm = rowv;
        if (m + 1 < MT) {
          rowv += 16;
          asm volatile("" : "+v"(rowv));
#pragma unroll
          for (int j = 0; j < 4; ++j) {
            const float4 t = *(const float4*)(XSRC(rowv + j) + (size_t)(rowv + j) * 1024 + col);
            if (m & 1) xa[j] = t; else xb[j] = t;
          }
        }
#pragma unroll
        for (int j = 0; j < 4; ++j) {
          const float4 xr = (m & 1) ? xb[j] : xa[j];
          const bool lo = cond_index(rowm + j) == ci_lo;
          float v0 = ALPHA_F * xr.x + gs * (lo ? gt_lo.x : gt_hi.x) * acc[m][0][j];
          float v1 = ALPHA_F * xr.y + gs * (lo ? gt_lo.y : gt_hi.y) * acc[m][1][j];
          float v2 = ALPHA_F * xr.z + gs * (lo ? gt_lo.z : gt_hi.z) * acc[m][2][j];
          float v3 = ALPHA_F * xr.w + gs * (lo ? gt_lo.w : gt_hi.w) * acc[m][3][j];
          acc[m][0][j] = v0; acc[m][1][j] = v1; acc[m][2][j] = v2; acc[m][3][j] = v3;
          float2 pr;
          pr.x = (v0 + v1) + (v2 + v3);
          pr.y = (v0 * v0 + v1 * v1) + (v2 * v2 + v3 * v3);
          *(float2*)(lsm + ((rl0 + m * 16 + j) * 65 + wc * 16 + fr) * 2) = pr;
        }
        SCHED();
      }
    }
    __syncthreads();
    unsigned long long* stats = (unsigned long long*)(ws + OFF_STATS);
    unsigned* cnt = (unsigned*)(ws + OFF_BAR) + LNCNT_WORD + pm;
    const int rr = tid_ >> 1, hh = tid_ & 1;
    if (tid_ < 384) {
      float s1 = 0.f, s2 = 0.f;
#pragma unroll 8
      for (int e = 0; e < 32; ++e) {
        float2 t = *(const float2*)(lsm + (rr * 65 + hh * 32 + e) * 2);
        s1 += t.x;
        s2 += t.y;
      }
      s1 += shfl_xor_f(s1, 1, lane);
      s2 += shfl_xor_f(s2, 1, lane);
      if (hh == 0) {
        unsigned long long pk = ((unsigned long long)__float_as_uint(s2) << 32) | (unsigned long long)__float_as_uint(s1);
        __hip_atomic_store(stats + (size_t)(brow + rr) * 4 + pn, pk, __ATOMIC_RELAXED, __HIP_MEMORY_SCOPE_AGENT);
      }
    }
    asm volatile("s_waitcnt vmcnt(0)" ::: "memory");
    __syncthreads();
    if (tid_ == 0) {
      __hip_atomic_fetch_add(cnt, 1u, __ATOMIC_RELAXED, __HIP_MEMORY_SCOPE_AGENT);
      const unsigned target = 4u * (unsigned)(l * 3 + lnidx + 1);
      unsigned sp = 0;
      while (__hip_atomic_load(cnt, __ATOMIC_RELAXED, __HIP_MEMORY_SCOPE_AGENT) < target) {
        __builtin_amdgcn_s_sleep(1);
        if (++sp > (1u << 24)) break;
      }
    }
    __syncthreads();
    if (tid_ < 384 && hh == 0) {
      float s1 = 0.f, s2 = 0.f;
#pragma unroll
      for (int q = 0; q < 4; ++q) {
        unsigned long long pk = __hip_atomic_load(stats + (size_t)(brow + rr) * 4 + q, __ATOMIC_RELAXED, __HIP_MEMORY_SCOPE_AGENT);
        s1 += __uint_as_float((unsigned)(pk & 0xffffffffull));
        s2 += __uint_as_float((unsigned)(pk >> 32));
      }
      const float mu = s1 * (1.f / 1024.f);
      const float var = fmaxf(s2 * (1.f / 1024.f) - mu * mu, 0.f);
      float2 st;
      st.x = mu;
      st.y = rsqrtf(var + 1e-5f);
      *(float2*)(lsm + 25600 + rr * 2) = st;
    }
    __syncthreads();
    int row0b = row0, colb = col, rl0b = rl0;
    asm volatile("" : "+v"(row0b), "+v"(colb), "+v"(rl0b));
    const bool last = (lnidx == 2) && (l == NLAYER - 1);
    const float4 lg = *(const float4*)(p.ln_g + (size_t)(l * 3 + lnidx) * 1024 + colb);
    const float4 lb = *(const float4*)(p.ln_b + (size_t)(l * 3 + lnidx) * 1024 + colb);
    const int ml = (lnidx == 2) ? l + 1 : l;
    const int sidx = (lnidx == 0) ? 3 : (lnidx == 1 ? 6 : 0);
    float* xdst = last ? p.out : xres;
    u16* hdst = (u16*)(ws + OFF_H);
    float4 sh_lo, sc_lo, sh_hi, sc_hi;
    if (!last) {
      const float* mlo = modb + ((size_t)(ml * 5 + ci_lo) * 9 + sidx) * 1024 + colb;
      const float* mhi = modb + ((size_t)(ml * 5 + ci_hi) * 9 + sidx) * 1024 + colb;
      sh_lo = *(const float4*)mlo; sc_lo = *(const float4*)(mlo + 1024);
      sh_hi = *(const float4*)mhi; sc_hi = *(const float4*)(mhi + 1024);
    }
    {
      int rowv = row0b;
#pragma unroll
      for (int m = 0; m < MT; ++m) {
        asm volatile("" : "+v"(rowv));
#pragma unroll
        for (int j = 0; j < 4; ++j) {
          const int row = rowv + j;
          const float2 st = *(const float2*)(lsm + 25600 + (rl0b + m * 16 + j) * 2);
          float4 x;
          x.x = (acc[m][0][j] - st.x) * st.y * lg.x + lb.x;
          x.y = (acc[m][1][j] - st.x) * st.y * lg.y + lb.y;
          x.z = (acc[m][2][j] - st.x) * st.y * lg.z + lb.z;
          x.w = (acc[m][3][j] - st.x) * st.y * lg.w + lb.w;
          *(float4*)(xdst + (size_t)row * 1024 + colb) = x;
          if (!last) {
            const bool lo = cond_index(row) == ci_lo;
            uint2 o;
            o.x = pack2(x.x * (1.f + (lo ? sc_lo.x : sc_hi.x)) + (lo ? sh_lo.x : sh_hi.x),
                        x.y * (1.f + (lo ? sc_lo.y : sc_hi.y)) + (lo ? sh_lo.y : sh_hi.y));
            o.y = pack2(x.z * (1.f + (lo ? sc_lo.z : sc_hi.z)) + (lo ? sh_lo.z : sh_hi.z),
                        x.w * (1.f + (lo ? sc_lo.w : sc_hi.w)) + (lo ? sh_lo.w : sh_hi.w));
            *(uint2*)(hdst + (size_t)row * 1024 + colb) = o;
          }
        }
        rowv += 16;
        SCHED();
      }
    }
  } else if constexpr (kind == K_IN) {
    if (pn < 3) {
      float* proj = (float*)(ws + OFF_V) + (size_t)row0 * PROJ_W + bcol + wc * 64 + fr * 4;
#pragma unroll
      for (int m = 0; m < MT; ++m) {
#pragma unroll
        for (int j = 0; j < 4; ++j) {
          float4 o;
          o.x = acc[m][0][j]; o.y = acc[m][1][j]; o.z = acc[m][2][j]; o.w = acc[m][3][j];
          *(float4*)(proj + (size_t)(m * 16 + j) * PROJ_W) = o;
        }
        SCHED();
      }
    } else {
      u16* uxg = (u16*)(ws + OFF_XCF) + (size_t)row0 * 1024 + (bcol - 768) + wc * 64 + fr * 4;
#pragma unroll
      for (int m = 0; m < MT; ++m) {
#pragma unroll
        for (int j = 0; j < 4; ++j) {
          uint2 o;
          o.x = pack2(acc[m][0][j], acc[m][1][j]);
          o.y = pack2(acc[m][2][j], acc[m][3][j]);
          *(uint2*)(uxg + (size_t)(m * 16 + j) * 1024) = o;
        }
        SCHED();
      }
    }
  } else if constexpr (kind == K_Q) {
    const float* rope = (const float*)(ws + OFF_ROPE);
#pragma unroll
    for (int g2 = 0; g2 < 2; ++g2) {
      const int cb = bcol + wc * 64 + g2 * 32;
      const bool is_rope = (brow >= NCTX) && ((cb % 96) == 64);
      u16* q = (u16*)(ws + OFF_Q) + (size_t)row0 * 768 + cb + fr;
#pragma unroll
      for (int m = 0; m < MT; ++m) {
#pragma unroll
        for (int j = 0; j < 4; ++j) {
          float x1 = acc[m][2 * g2][j], x2 = acc[m][2 * g2 + 1][j];
          if (is_rope) {
            int t = (row0 + m * 16 + j - NCTX) & 1023;
            float cs = rope[t * 32 + fr], sn = rope[t * 32 + 16 + fr];
            float o1 = x1 * cs - x2 * sn, o2 = x1 * sn + x2 * cs;
            x1 = o1;
            x2 = o2;
          }
          q[(m * 16 + j) * 768] = f2bf(x1 * QSCALE);
          q[(m * 16 + j) * 768 + 16] = f2bf(x2 * QSCALE);
        }
        SCHED();
      }
    }
  } else if constexpr (kind == K_KV) {
    size_t vbase;
    int key0, Tk;
    if (brow < NCTX) {
      int b = brow >> 8;
      vbase = (size_t)b * 512 * 256;
      key0 = 0;
      Tk = 256;
    } else {
      int rr = brow - NCTX;
      int b = rr / 1280;
      key0 = rr - b * 1280;
      vbase = (size_t)NCTX * 512 + (size_t)b * 512 * 1280;
      Tk = 1280;
    }
    const int h = pn * 2 + (wc >> 1);
    if ((wc & 1) == 0) {
      u16* kn = (u16*)(ws + OFF_KN) + (size_t)row0 * 512 + h * 64 + fr;
#pragma unroll
      for (int m = 0; m < MT; ++m) {
#pragma unroll
        for (int j = 0; j < 4; ++j)
#pragma unroll
          for (int n = 0; n < 4; ++n) kn[(m * 16 + j) * 512 + n * 16] = f2bf(acc[m][n][j]);
        SCHED();
      }
    } else {
      u16* vt = (u16*)(ws + OFF_VT) + vbase + (size_t)(h * 64 + fr) * Tk + key0 + wr * 128 + fq * 4;
#pragma unroll
      for (int m = 0; m < MT; ++m) {
#pragma unroll
        for (int n = 0; n < 4; ++n) {
          uint2 pk;
          pk.x = pack2(acc[m][n][0], acc[m][n][1]);
          pk.y = pack2(acc[m][n][2], acc[m][n][3]);
          *(uint2*)(vt + (size_t)(n * 16) * Tk + m * 16) = pk;
        }
        SCHED();
      }
    }
  } else if constexpr (kind == K_GATE) {
    const int ch = pn * 64 + wc * 16 + fr;
    const size_t o0 = (size_t)row0 * 512 + ch;
    uint2* au = (uint2*)(ws + OFF_ACT) + o0;
    const u16* xcb = (const u16*)(ws + OFF_XC) + o0;
    float ba[2], bx[2], sp[2];
#pragma unroll
    for (int d = 0; d < 2; ++d) {
      const int pidx = (l * 2 + d) * 512 + ch;
      ba[d] = p.lru_b_a[pidx];
      bx[d] = p.lru_b_x[pidx];
      sp[d] = -8.f * log1pf(__expf(-p.lru_lambda[pidx]));
    }
#pragma unroll
    for (int m = 0; m < MT; ++m) {
#pragma unroll
      for (int j = 0; j < 4; ++j) {
        const int idx = (m * 16 + j) * 512;
        const float xv = __uint_as_float((unsigned)xcb[idx] << 16);
        unsigned w[2];
#pragma unroll
        for (int d = 0; d < 2; ++d) {
          float rg = sigmoid_f(acc[m][d * 2][j] + ba[d]);
          float ig = sigmoid_f(acc[m][d * 2 + 1][j] + bx[d]);
          float la = rg * sp[d];
          unsigned q = (unsigned)fminf(-la * 32768.f + 0.5f, 65535.f);
          float a = __expf(-(float)q * (1.f / 32768.f));
          float mult = __builtin_amdgcn_sqrtf(fmaxf(1.f - a * a, 0.f));
          w[d] = (pack2(0.f, mult * ig * xv) & 0xffff0000u) | q;
        }
        uint2 o;
        o.x = w[0];
        o.y = w[1];
        au[idx] = o;
      }
      SCHED();
    }
  }
}

DEVI void tile_map(int Lp, int nM, int nN, int& pm, int& pn) {
  int nig = 8 * nN, gid = Lp / nig, fm = gid * 8, gsz = min(nM - fm, 8);
  int w = Lp % nig;
  pm = fm + w % gsz;
  pn = w / gsz;
}

template <int kind, int MT>
DEVI void gemm_phase(int wv_, const P& p, const u16* A, const u16* B, int lda, int ldb, int K, int nM, int nN, int l, int sub, int rot) {
  const int G = gridDim.x, bid = blockIdx.x;
  const int total = nM * nN;
  const int per = G >> 3;
  int idx = (bid & 7) * per + (bid >> 3) + rot;
  if (idx >= G) idx -= G;
  int L = idx;
  if (L >= total) return;
  int pm, pn;
  tile_map(L, nM, nN, pm, pn);
  const u16* Ap = A;
  const u16* Bp = B;
  int bcol = pn * 256;
  if constexpr (kind == K_GATE) {
    Ap = A + pn * 64;
    Bp = B + (size_t)pn * 256 * 64;
    bcol = 0;
  }
  if constexpr (MT != 6) gemm_stage0<MT>(wv_, Ap, lda, Bp, ldb, pm * (MT * 32), bcol);
  for (;;) {
    f32x4 acc[MT][4];
    if constexpr (MT == 6) gemm_core_8p(wv_, Ap, lda, Bp, ldb, K, pm * (MT * 32), bcol, acc);
    else gemm_core<MT>(wv_, Ap, lda, Bp, ldb, K, pm * (MT * 32), bcol, acc);
    const int cpm = pm, cpn = pn;
    L += G;
    const bool more = L < total;
    if (more) {
      tile_map(L, nM, nN, pm, pn);
      Ap = A;
      Bp = B;
      bcol = pn * 256;
      if constexpr (kind == K_GATE) {
        Ap = A + pn * 64;
        Bp = B + (size_t)pn * 256 * 64;
        bcol = 0;
      }
      if constexpr (MT != 6) gemm_stage0<MT>(wv_, Ap, lda, Bp, ldb, pm * (MT * 32), bcol);
    }
    gemm_epilogue<kind, MT>(wv_, p, l, sub, cpm, cpn, acc);
    if (!more) break;
  }
  __syncthreads();
}

constexpr int CONV_TILES = 5064;
DEVI void convert_layer_tiles(int wv_, const P& p, int layer, int first, int last, int wslot, int nslots) {
  char* ws = p.ws;
  const int tid = get_tid(wv_);
  const int wid = tid >> 6, lane = tid & 63;
  u16* tl = shm + wid * (64 * 72);
  const int nq = lane & 15, kr = lane >> 4;
  for (int ti = first + wslot; ti < last; ti += nslots) {
    const float* src;
    u16* dst;
    int K, Nsrc, Np, job, local, mat;
    if (ti < 2816) { job = 0; mat = layer * 2 + (ti >= 1408); local = ti % 1408; K = 1024; Nsrc = 5632; Np = 5632; }
    else if (ti < 4224) { job = 1; mat = layer * 2 + (ti >= 3520); local = (ti - 2816) % 704; K = 2816; Nsrc = 1024; Np = 1024; }
    else if (ti < 4672) { job = 2; mat = layer; local = ti - 4224; K = 1024; Nsrc = 1696; Np = 1792; }
    else if (ti < 4744) { job = 3; mat = layer; local = ti - 4672; K = 384; Nsrc = 768; Np = 768; }
    else if (ti < 4808) { job = 4; mat = layer; local = ti - 4744; K = 256; Nsrc = 1024; Np = 1024; }
    else { job = 5; mat = layer; local = ti - 4808; K = 1024; Nsrc = 1024; Np = 1024; }
    int kt = local / (Np / 64), nt = local % (Np / 64);
    switch (job) {
      case 0: src = p.w_up; dst = (u16*)(ws + OFF_WUP); break;
      case 1: src = p.w_down; dst = (u16*)(ws + OFF_WDN); break;
      case 2: src = p.w_in; dst = (u16*)(ws + OFF_WIN); break;
      case 3: src = p.w_uq; dst = (u16*)(ws + OFF_WUQ); break;
      case 4: src = p.w_ukv; dst = (u16*)(ws + OFF_WUKV); break;
      default: src = p.w_o; dst = (u16*)(ws + OFF_WO); break;
    }
    src += (size_t)mat * K * Nsrc;
    dst += (size_t)mat * Np * K;
    const int np = nt * 64 + nq * 4;
    int sc;
    if (job == 0) {
      int j = np >> 8, w = np & 255, wcg = w >> 6, x = w & 63;
      sc = x < 32 ? j * 128 + wcg * 32 + x : 2816 + j * 128 + wcg * 32 + (x - 32);
    } else if (job == 2) {
      sc = np < 672 ? np : (np < 768 ? -1 : np - 96);
    } else sc = np;
    const float* sp = src + (size_t)(kt * 64 + kr * 4) * Nsrc + (sc >= 0 ? sc : 0);
    float4 r[4][4];
#pragma unroll
    for (int kb = 0; kb < 4; ++kb)
#pragma unroll
      for (int e = 0; e < 4; ++e) {
        float4 v = *(const float4*)(sp + (size_t)(kb * 16 + e) * Nsrc);
        if (sc < 0) v = float4{0.f, 0.f, 0.f, 0.f};
        r[kb][e] = v;
      }
    int lr0 = nq * 4, lr1 = nq * 4 + 1, lr2 = nq * 4 + 2, lr3 = nq * 4 + 3;
    if (job == 0) {
      const int hb = (nq >> 3) * 32, s0 = (nq & 7) * 4;
      lr0 = hb + (s0 >> 1);
      lr1 = hb + 16 + (s0 >> 1);
      lr2 = hb + (s0 >> 1) + 1;
      lr3 = hb + 16 + (s0 >> 1) + 1;
    } else if (job == 1 || job == 2 || job == 5) {
      lr0 = nq; lr1 = 16 + nq; lr2 = 32 + nq; lr3 = 48 + nq;
    }
#pragma unroll
    for (int kb = 0; kb < 4; ++kb) {
      const int k = kb * 16 + kr * 4;
      uint2 o;
      o.x = pack2(r[kb][0].x, r[kb][1].x); o.y = pack2(r[kb][2].x, r[kb][3].x);
      *(uint2*)(tl + lr0 * 72 + k) = o;
      o.x = pack2(r[kb][0].y, r[kb][1].y); o.y = pack2(r[kb][2].y, r[kb][3].y);
      *(uint2*)(tl + lr1 * 72 + k) = o;
      o.x = pack2(r[kb][0].z, r[kb][1].z); o.y = pack2(r[kb][2].z, r[kb][3].z);
      *(uint2*)(tl + lr2 * 72 + k) = o;
      o.x = pack2(r[kb][0].w, r[kb][1].w); o.y = pack2(r[kb][2].w, r[kb][3].w);
      *(uint2*)(tl + lr3 * 72 + k) = o;
    }
    asm volatile("s_waitcnt lgkmcnt(0)" ::: "memory");
    {
      const int seg = lane & 7, nr = lane >> 3;
#pragma unroll
      for (int j = 0; j < 8; ++j) {
        int n = j * 8 + nr;
        uint4 v = *(const uint4*)(tl + n * 72 + seg * 8);
        *(uint4*)(dst + (size_t)(nt * 64 + n) * K + kt * 64 + seg * 8) = v;
      }
    }
    asm volatile("s_waitcnt lgkmcnt(0)" ::: "memory");
  }
  __syncthreads();
}

DEVI void mod_layer(int wv_, const P& p, int l, int first, int stride) {
  const int tid = get_tid(wv_);
  char* ws = p.ws;
  float* sf = (float*)shm;
  float* scond = sf;
  float* red = sf + 5 * 1024;
  for (int i = tid; i < 5 * 1024; i += 512) {
    int ci = i >> 10, k = i & 1023;
    float cv = ci == 0 ? p.c_ctx[k] : p.c[(ci - 1) * 1024 + k];
    scond[i] = silu_f(cv);
  }
  __syncthreads();
  const int cgp = tid & 15, ks = tid >> 4;
  for (int ch = first; ch < 144; ch += stride) {
    const int col0 = ch * 64;
    float a[5][4];
#pragma unroll
    for (int ci = 0; ci < 5; ++ci)
#pragma unroll
      for (int e = 0; e < 4; ++e) a[ci][e] = 0.f;
    const float* wp = p.w_mod + ((size_t)l * 1024 + ks * 32) * 9216 + col0 + cgp * 4;
#pragma unroll 8
    for (int kk = 0; kk < 32; ++kk) {
      float4 w = *(const float4*)(wp + (size_t)kk * 9216);
      int k = ks * 32 + kk;
#pragma unroll
      for (int ci = 0; ci < 5; ++ci) {
        float s = scond[ci * 1024 + k];
        a[ci][0] += s * w.x;
        a[ci][1] += s * w.y;
        a[ci][2] += s * w.z;
        a[ci][3] += s * w.w;
      }
    }
#pragma unroll
    for (int ci = 0; ci < 5; ++ci)
#pragma unroll
      for (int e = 0; e < 4; ++e) red[(ks * 5 + ci) * 64 + cgp * 4 + e] = a[ci][e];
    __syncthreads();
    if (tid < 320) {
      int ci = tid >> 6, cc = tid & 63;
      float s = 0.f;
      for (int k2 = 0; k2 < 32; ++k2) s += red[(k2 * 5 + ci) * 64 + cc];
      s += p.b_mod[(size_t)l * 9216 + col0 + cc];
      ((float*)(ws + OFF_MOD))[((size_t)l * 5 + ci) * 9216 + col0 + cc] = s;
    }
    __syncthreads();
  }
}

DEVI void prep_phase(int wv_, const P& p) {
  const int G = gridDim.x, bid = blockIdx.x, tid = get_tid(wv_);
  char* ws = p.ws;
  float* sf = (float*)shm;
  for (int ml = 0; ml < NLAYER; ++ml) mod_layer(wv_, p, ml, (bid + ml * 112) % G, G);
  convert_layer_tiles(wv_, p, 0, 0, CONV_TILES, bid * 8 + (tid >> 6), G * 8);
  {
    u16* wg = (u16*)(ws + OFF_WG);
    const int total = 4 * 8 * 256 * 64;
    for (int i = bid * 512 + tid; i < total; i += G * 512) {
      int k = i & 63, row = (i >> 6) & 255, nb = (i >> 14) & 7, l = i >> 17;
      int wcg = row >> 6, n = (row >> 4) & 3, fr = row & 15;
      int dir = n >> 1, gt = n & 1, e = wcg * 16 + fr;
      const float* w = gt == 0 ? p.lru_w_a : p.lru_w_x;
      wg[i] = f2bf(w[((((size_t)l * 2 + dir) * 8 + nb) * 64 + k) * 64 + e]);
    }
  }
  {
    float* rope = (float*)(ws + OFF_ROPE);
    for (int i = bid * 512 + tid; i < 1024 * 16; i += G * 512) {
      int t = i >> 4, f = i & 15;
      float pos = (f < 8) ? (float)(t >> 6) : (float)(t & 63);
      float inv = powf(10000.f, -(float)(f & 7) / 8.f);
      float ang = pos * inv;
      rope[t * 32 + f] = cosf(ang);
      rope[t * 32 + 16 + f] = sinf(ang);
    }
  }
}

DEVI void ln_phase(int wv_, const P& p, bool do_ln, int lnl, int lnidx, bool write_h, int ml, int shift_idx, bool final_out) {
  const int G = gridDim.x, bid = blockIdx.x, tid_ = get_tid(wv_), wid = tid_ >> 6, lane = tid_ & 63;
  char* ws = p.ws;
  const float* v = (const float*)(ws + OFF_V);
  float* xres = (float*)(ws + OFF_XRES);
  u16* h = (u16*)(ws + OFF_H);
  const float* modb = (const float*)(ws + OFF_MOD);
  for (int row = (bid * 8 + wid); row < NTOK; row += G * 8) {
    float4 x[4];
    if (do_ln) {
      const float4* vr = (const float4*)(v + (size_t)row * 1024);
      float s = 0.f;
#pragma unroll
      for (int i = 0; i < 4; ++i) {
        x[i] = vr[lane + 64 * i];
        s += x[i].x + x[i].y + x[i].z + x[i].w;
      }
      float mu = wave_sum(s, lane) * (1.f / 1024.f);
      float s2 = 0.f;
#pragma unroll
      for (int i = 0; i < 4; ++i) {
        x[i].x -= mu; x[i].y -= mu; x[i].z -= mu; x[i].w -= mu;
        s2 += x[i].x * x[i].x + x[i].y * x[i].y + x[i].z * x[i].z + x[i].w * x[i].w;
      }
      float rstd = rsqrtf(wave_sum(s2, lane) * (1.f / 1024.f) + 1e-5f);
      const float4* gp = (const float4*)(p.ln_g + (size_t)(lnl * 3 + lnidx) * 1024);
      const float4* bp = (const float4*)(p.ln_b + (size_t)(lnl * 3 + lnidx) * 1024);
      float4* dst = final_out ? (float4*)(p.out + (size_t)row * 1024) : (float4*)(xres + (size_t)row * 1024);
#pragma unroll
      for (int i = 0; i < 4; ++i) {
        float4 g = gp[lane + 64 * i], b = bp[lane + 64 * i];
        x[i].x = x[i].x * rstd * g.x + b.x;
        x[i].y = x[i].y * rstd * g.y + b.y;
        x[i].z = x[i].z * rstd * g.z + b.z;
        x[i].w = x[i].w * rstd * g.w + b.w;
        dst[lane + 64 * i] = x[i];
      }
    } else {
      const float4* xr = (const float4*)(row < NCTX ? p.x_prompt + (size_t)row * 1024 : p.x_sample + (size_t)(row - NCTX) * 1024);
#pragma unroll
      for (int i = 0; i < 4; ++i) x[i] = xr[lane + 64 * i];
    }
    if (write_h) {
      const int ci = cond_index(row);
      const float4* sh = (const float4*)(modb + ((size_t)(ml * 5 + ci) * 9 + shift_idx) * 1024);
      const float4* sc = (const float4*)(modb + ((size_t)(ml * 5 + ci) * 9 + shift_idx + 1) * 1024);
      uint2* hd = (uint2*)(h + (size_t)row * 1024);
#pragma unroll
      for (int i = 0; i < 4; ++i) {
        float4 a = sh[lane + 64 * i], b = sc[lane + 64 * i];
        uint2 o;
        o.x = pack2(x[i].x * (1.f + b.x) + a.x, x[i].y * (1.f + b.y) + a.y);
        o.y = pack2(x[i].z * (1.f + b.z) + a.z, x[i].w * (1.f + b.w) + a.w);
        hd[lane + 64 * i] = o;
      }
    }
  }
}

DEVI void post_phase(int wv_, const P& p, int l) {
  const int G = gridDim.x, bid = blockIdx.x, tid_ = get_tid(wv_), wid = tid_ >> 6, lane = tid_ & 63;
  char* ws = p.ws;
  const float* proj = (const float*)(ws + OFF_V);
  u16* cqn = (u16*)(ws + OFF_CQN);
  u16* ckvn = (u16*)(ws + OFF_CKVN);
  u16* kr = (u16*)(ws + OFF_KR);
  u16* xc = (u16*)(ws + OFF_XC);
  const float* rope = (const float*)(ws + OFF_ROPE);
  const u16* uxg = (const u16*)(ws + OFF_XCF);
  float4 cw[2][4], cbias[2];
#pragma unroll
  for (int i = 0; i < 2; ++i) {
    const int ch = lane * 4 + 256 * i;
    cbias[i] = *(const float4*)(p.conv_b + l * 512 + ch);
#pragma unroll
    for (int k = 0; k < 4; ++k) cw[i][k] = *(const float4*)(p.conv_w + (size_t)(l * 4 + k) * 512 + ch);
  }
  float gq[6];
#pragma unroll
  for (int i = 0; i < 6; ++i) gq[i] = p.qg[l * 384 + lane + 64 * i];
  const float4 gkv = *(const float4*)(p.kvg + l * 256 + lane * 4);
  const int l15 = lane & 15;
  for (int r0 = bid * 8 + wid; r0 < NTOK; r0 += 2 * G * 8) {
    float cq[2][6];
    float4 cv[2], xv[2][2][4];
    float x1[2], x2[2], rcs[2], rsn[2];
    int tt[2], TT[2], bb[2];
    bool ctx[2], ok[2];
#pragma unroll
    for (int q = 0; q < 2; ++q) {
      const int r = r0 + q * G * 8;
      ok[q] = r < NTOK;
      const int rc = ok[q] ? r : r0;
      ctx[q] = rc < NCTX;
      if (ctx[q]) { bb[q] = rc >> 8; tt[q] = rc & 255; TT[q] = 256; }
      else { int rr = rc - NCTX; bb[q] = rr >> 10; tt[q] = rr & 1023; TT[q] = 1024; }
      const float* pr = proj + (size_t)rc * PROJ_W;
#pragma unroll
      for (int i = 0; i < 6; ++i) cq[q][i] = pr[lane + 64 * i];
      cv[q] = *(const float4*)(pr + 384 + lane * 4);
      x1[q] = pr[640 + l15];
      x2[q] = pr[656 + l15];
      rcs[q] = rope[(tt[q] & 1023) * 32 + l15];
      rsn[q] = rope[(tt[q] & 1023) * 32 + 16 + l15];
#pragma unroll
      for (int i = 0; i < 2; ++i)
#pragma unroll
        for (int k = 0; k < 4; ++k) {
          const int t2 = tt[q] - 2 + k;
          const bool v = (t2 >= 0) && (t2 < TT[q]);
          const uint2 raw = *(const uint2*)(uxg + ((size_t)rc + (v ? k - 2 : 0)) * 1024 + lane * 4 + 256 * i);
          float4 f;
          f.x = __uint_as_float(raw.x << 16); f.y = __uint_as_float(raw.x & 0xffff0000u);
          f.z = __uint_as_float(raw.y << 16); f.w = __uint_as_float(raw.y & 0xffff0000u);
          xv[q][i][k] = v ? f : float4{0.f, 0.f, 0.f, 0.f};
        }
    }
#pragma unroll
    for (int q = 0; q < 2; ++q) {
      if (!ok[q]) continue;
      const int r = r0 + q * G * 8;
      const int b = bb[q], t = tt[q];
      const size_t rowp = ctx[q] ? (size_t)r : (size_t)NCTX + b * 1280 + 256 + t;
      {
        float ss = 0.f;
#pragma unroll
        for (int i = 0; i < 6; ++i) ss += cq[q][i] * cq[q][i];
        const float rstd = rsqrtf(wave_sum(ss, lane) * (1.f / 384.f) + 1e-6f);
#pragma unroll
        for (int i = 0; i < 6; ++i) cqn[(size_t)r * 384 + lane + 64 * i] = f2bf(cq[q][i] * rstd * gq[i]);
      }
      {
        float4 c4 = cv[q];
        float ss = c4.x * c4.x + c4.y * c4.y + c4.z * c4.z + c4.w * c4.w;
        const float rstd = rsqrtf(wave_sum(ss, lane) * (1.f / 256.f) + 1e-6f);
        c4.x *= rstd * gkv.x; c4.y *= rstd * gkv.y; c4.z *= rstd * gkv.z; c4.w *= rstd * gkv.w;
        if (ctx[q]) *(float4*)(p.out + OUT_CKV + ((size_t)(b * 4 + l) * 256 + t) * 256 + lane * 4) = c4;
        uint2 o;
        o.x = pack2(c4.x, c4.y);
        o.y = pack2(c4.z, c4.w);
        *(uint2*)(ckvn + rowp * 256 + lane * 4) = o;
      }
      if (lane < 16) {
        float a1 = x1[q], a2 = x2[q];
        if (ctx[q]) {
          float* okp = p.out + OUT_KROPE + ((size_t)(b * 4 + l) * 256 + t) * 32;
          okp[lane] = a1;
          okp[16 + lane] = a2;
        } else {
          const float o1 = a1 * rcs[q] - a2 * rsn[q], o2 = a1 * rsn[q] + a2 * rcs[q];
          a1 = o1;
          a2 = o2;
        }
        kr[rowp * 32 + lane] = f2bf(a1);
        kr[rowp * 32 + 16 + lane] = f2bf(a2);
      }
#pragma unroll
      for (int i = 0; i < 2; ++i) {
        const int ch = lane * 4 + 256 * i;
        float4 av = cbias[i];
#pragma unroll
        for (int k = 0; k < 4; ++k) {
          av.x += xv[q][i][k].x * cw[i][k].x;
          av.y += xv[q][i][k].y * cw[i][k].y;
          av.z += xv[q][i][k].z * cw[i][k].z;
          av.w += xv[q][i][k].w * cw[i][k].w;
        }
        uint2 o;
        o.x = pack2(av.x, av.y);
        o.y = pack2(av.z, av.w);
        *(uint2*)(xc + (size_t)r * 512 + ch) = o;
      }
    }
  }
  for (int idx = bid * 8 + wid; idx < 1024; idx += G * 8) {
    const int b = idx >> 8, pp = idx & 255;
    const size_t rowp = (size_t)NCTX + b * 1280 + pp;
    const float4 c4 = *(const float4*)(p.cache_ckv + ((size_t)(b * 4 + l) * 256 + pp) * 256 + lane * 4);
    uint2 o;
    o.x = pack2(c4.x, c4.y);
    o.y = pack2(c4.z, c4.w);
    *(uint2*)(ckvn + rowp * 256 + lane * 4) = o;
    if (lane < 32) kr[rowp * 32 + lane] = f2bf(p.cache_krope[((size_t)(b * 4 + l) * 256 + pp) * 32 + lane]);
  }
}

constexpr int KS_STRIDE = 104;
constexpr int VS_STRIDE = 72;
constexpr int KS_ELEMS = 64 * KS_STRIDE, VS_ELEMS = 64 * VS_STRIDE;

DEVI void attn_item(int wv_, const P& p, int item) {
  const int tid = get_tid(wv_), wid = tid >> 6, lane = tid & 63, fr = lane & 15, fq = lane >> 4;
  char* ws = p.ws;
  const u16* q = (const u16*)(ws + OFF_Q);
  const u16* kn = (const u16*)(ws + OFF_KN);
  const u16* kr = (const u16*)(ws + OFF_KR);
  const u16* vt = (const u16*)(ws + OFF_VT);
  u16* mix = (u16*)(ws + OFF_MIX);
  int h, r0, rowp0, Tk;
  size_t vbase;
  if (item < 128) {
    int b = item >> 5, qb = item & 3;
    h = (item >> 2) & 7;
    r0 = NCTX + b * 1024 + qb * 256;
    rowp0 = NCTX + b * 1280;
    Tk = 1280;
    vbase = (size_t)NCTX * 512 + (size_t)b * 512 * 1280 + (size_t)h * 64 * 1280;
  } else {
    int it = item - 128, b = it >> 3;
    h = it & 7;
    r0 = b * 256;
    rowp0 = b * 256;
    Tk = 256;
    vbase = (size_t)b * 512 * 256 + (size_t)h * 64 * 256;
  }
  u16* Ks = shm;
  u16* Vs = shm + 2 * KS_ELEMS;
  bf16x8 qf[2][3];
#pragma unroll
  for (int nb = 0; nb < 2; ++nb)
#pragma unroll
    for (int ks = 0; ks < 3; ++ks)
      qf[nb][ks] = *(const bf16x8*)(q + (size_t)(r0 + wid * 32 + nb * 16 + fr) * 768 + h * 96 + ks * 32 + fq * 8);
  f32x4 o[4][2];
#pragma unroll
  for (int db = 0; db < 4; ++db)
#pragma unroll
    for (int nb = 0; nb < 2; ++nb) o[db][nb] = f32x4{0.f, 0.f, 0.f, 0.f};
  float mrun[2] = {-INFINITY, -INFINITY}, lrun[2] = {0.f, 0.f};
  const int ntile = Tk >> 6;
  uint4 gk, gv, gr;
  const int skey = tid >> 3, sseg = tid & 7;
  const int rkey = tid >> 2, rseg = tid & 3;
  auto gload = [&](int kt) {
    int k0 = kt * 64;
    gk = *(const uint4*)(kn + (size_t)(rowp0 + k0 + skey) * 512 + h * 64 + sseg * 8);
    gv = *(const uint4*)(vt + vbase + (size_t)skey * Tk + k0 + sseg * 8);
    if (tid < 256) gr = *(const uint4*)(kr + (size_t)(rowp0 + k0 + rkey) * 32 + rseg * 8);
  };
  auto lstore = [&](int buf) {
    *(uint4*)(Ks + buf * KS_ELEMS + skey * KS_STRIDE + sseg * 8) = gk;
    *(uint4*)(Vs + buf * VS_ELEMS + skey * VS_STRIDE + sseg * 8) = gv;
    if (tid < 256) *(uint4*)(Ks + buf * KS_ELEMS + rkey * KS_STRIDE + 64 + rseg * 8) = gr;
  };
  gload(0);
  lstore(0);
  __syncthreads();
  for (int kt = 0; kt < ntile; ++kt) {
    const int buf = kt & 1;
    if (kt + 1 < ntile) gload(kt + 1);
    const u16* Kb = Ks + buf * KS_ELEMS;
    const u16* Vb = Vs + buf * VS_ELEMS;
    f32x4 s[4][2];
#pragma unroll
    for (int kb = 0; kb < 4; ++kb) {
      s[kb][0] = f32x4{0.f, 0.f, 0.f, 0.f};
      s[kb][1] = f32x4{0.f, 0.f, 0.f, 0.f};
#pragma unroll
      for (int ks = 0; ks < 3; ++ks) {
        bf16x8 kf = *(const bf16x8*)(Kb + (kb * 16 + fr) * KS_STRIDE + ks * 32 + fq * 8);
        s[kb][0] = __builtin_amdgcn_mfma_f32_16x16x32_bf16(kf, qf[0][ks], s[kb][0], 0, 0, 0);
        s[kb][1] = __builtin_amdgcn_mfma_f32_16x16x32_bf16(kf, qf[1][ks], s[kb][1], 0, 0, 0);
      }
    }
    bf16x8 pf[2][2];
#pragma unroll
    for (int nb = 0; nb < 2; ++nb) {
      float mx = s[0][nb][0];
#pragma unroll
      for (int kb = 0; kb < 4; ++kb)
#pragma unroll
        for (int j = 0; j < 4; ++j) mx = fmaxf(mx, s[kb][nb][j]);
      mx = fmaxf(mx, shfl_xor_f(mx, 16, lane));
      mx = fmaxf(mx, shfl_xor_f(mx, 32, lane));
      float mnew = fmaxf(mrun[nb], mx);
      float alpha = __builtin_amdgcn_exp2f(mrun[nb] - mnew);
      mrun[nb] = mnew;
      float ls = 0.f;
#pragma unroll
      for (int kb = 0; kb < 4; ++kb)
#pragma unroll
        for (int j = 0; j < 4; ++j) {
          float pv = __builtin_amdgcn_exp2f(s[kb][nb][j] - mnew);
          s[kb][nb][j] = pv;
          ls += pv;
        }
      lrun[nb] = lrun[nb] * alpha + ls;
#pragma unroll
      for (int db = 0; db < 4; ++db) {
        o[db][nb][0] *= alpha; o[db][nb][1] *= alpha; o[db][nb][2] *= alpha; o[db][nb][3] *= alpha;
      }
#pragma unroll
      for (int pp = 0; pp < 2; ++pp) {
        union { bf16x8 v; unsigned u[4]; } cv;
        cv.u[0] = pack2(s[2 * pp][nb][0], s[2 * pp][nb][1]);
        cv.u[1] = pack2(s[2 * pp][nb][2], s[2 * pp][nb][3]);
        cv.u[2] = pack2(s[2 * pp + 1][nb][0], s[2 * pp + 1][nb][1]);
        cv.u[3] = pack2(s[2 * pp + 1][nb][2], s[2 * pp + 1][nb][3]);
        pf[pp][nb] = cv.v;
      }
    }
#pragma unroll
    for (int db = 0; db < 4; ++db)
#pragma unroll
      for (int pp = 0; pp < 2; ++pp) {
        union { bf16x8 v; uint2 u[2]; } vf;
        vf.u[0] = *(const uint2*)(Vb + (db * 16 + fr) * VS_STRIDE + 32 * pp + fq * 4);
        vf.u[1] = *(const uint2*)(Vb + (db * 16 + fr) * VS_STRIDE + 32 * pp + 16 + fq * 4);
        o[db][0] = __builtin_amdgcn_mfma_f32_16x16x32_bf16(vf.v, pf[pp][0], o[db][0], 0, 0, 0);
        o[db][1] = __builtin_amdgcn_mfma_f32_16x16x32_bf16(vf.v, pf[pp][1], o[db][1], 0, 0, 0);
      }
    if (kt + 1 < ntile) lstore(buf ^ 1);
    __syncthreads();
  }
#pragma unroll
  for (int nb = 0; nb < 2; ++nb) {
    float lt = lrun[nb];
    lt += shfl_xor_f(lt, 16, lane);
    lt += shfl_xor_f(lt, 32, lane);
    float inv = 1.f / lt;
    int row = r0 + wid * 32 + nb * 16 + fr;
#pragma unroll
    for (int db = 0; db < 4; ++db) {
      uint2 pk;
      pk.x = pack2(o[db][nb][0] * inv, o[db][nb][1] * inv);
      pk.y = pack2(o[db][nb][2] * inv, o[db][nb][3] * inv);
      *(uint2*)(mix + (size_t)row * 1024 + h * 64 + db * 16 + fq * 4) = pk;
    }
  }
}

template <int LC, int CHB>
DEVI void scan_item_t(int wv_, const P& p, int l, int b, int cgi, int r0, bool is_ctx) {
  constexpr int CH = 1 << CHB, NCH = 256 / CH;
  const int tid = get_tid(wv_), c = tid & (CH - 1), dir = (tid >> CHB) & 1, k = tid >> (CHB + 1);
  char* ws = p.ws;
  const int ch = cgi * CH + c;
  const int t0 = k * LC;
  const int kk = dir ? NCH - 1 - k : k;
  const unsigned* ap = (const unsigned*)(ws + OFF_ACT) + ((size_t)(r0 + t0) * 512 + ch) * 2 + dir;
  const u16* ugp = (const u16*)(ws + OFF_XCF) + (size_t)(r0 + t0) * 1024 + 512 + ch;
  const int stride = dir ? -1024 : 1024;
  const int start = dir ? (LC - 1) * 1024 : 0;
  float a[LC], u[LC], ug[LC / 2];
#pragma unroll
  for (int i = 0; i < LC; ++i) {
    const unsigned t = ap[start + i * stride];
    a[i] = __expf(-(float)(t & 0xffffu) * (1.f / 32768.f));
    u[i] = __uint_as_float(t & 0xffff0000u);
  }
#pragma unroll
  for (int i = 0; i < LC; i += 2) ug[i / 2] = __uint_as_float((unsigned)ugp[(dir ? LC - 1 - i : i) * 1024] << 16);
  float* sm = (float*)shm;
  {
    float A = 1.f, H = 0.f;
#pragma unroll
    for (int i = 0; i < LC; ++i) {
      H = a[i] * H + u[i];
      A *= a[i];
    }
    sm[(dir * NCH + kk) * CH + c] = A;
    sm[512 + (dir * NCH + kk) * CH + c] = H;
  }
  __syncthreads();
  float h = is_ctx ? 0.f : p.state_lru[((size_t)(b * 4 + l) * 2 + dir) * 512 + ch];
  for (int j = 0; j < kk; ++j) h = sm[(dir * NCH + j) * CH + c] * h + sm[512 + (dir * NCH + j) * CH + c];
#pragma unroll
  for (int i = 0; i < LC; ++i) {
    h = a[i] * h + u[i];
    u[i] = h;
  }
  if (is_ctx && kk == NCH - 1) p.out[OUT_STATE + ((size_t)(b * 4 + l) * 2 + dir) * 512 + ch] = h;
  u16* mix = (u16*)(ws + OFF_MIX) + (size_t)(r0 + t0) * 1024 + 512 + ch;
  const int lane = tid & 63;
#pragma unroll
  for (int i = 0; i < LC; i += 2) {
    float other = shfl_xor_f(u[LC - 1 - i], CH, lane);
    float sum = u[i] + other;
    int t = dir ? LC - 1 - i : i;
    mix[(size_t)t * 1024] = f2bf(sum * gelu_tanh(ug[i / 2]));
  }
  __syncthreads();
}

DEVI void scan_item(int wv_, const P& p, int l, int si) {
  if (si < 128) {
    int b = si >> 5, cgi = si & 31;
    scan_item_t<64, 4>(wv_, p, l, b, cgi, NCTX + b * 1024, false);
  } else {
    int it = si - 128, b = it >> 4, cgi = it & 15;
    scan_item_t<32, 5>(wv_, p, l, b, cgi, b * 256, true);
  }
}

DEVI void mixer_phase(int wv_, const P& p, int l) {
  const int G = gridDim.x, bid = blockIdx.x;
  if (G == 256) {
    if (bid < 128) {
      attn_item(wv_, p, bid);
      __syncthreads();
    } else {
      attn_item(wv_, p, 128 + (bid - 128));
      __syncthreads();
      attn_item(wv_, p, 256 + (bid - 128));
      __syncthreads();
      scan_item(wv_, p, l, bid - 128);
    }
    for (int k = 0; k < 2; ++k) scan_item(wv_, p, l, 128 + k * 256 + bid);
  } else {
    for (int it = bid; it < 384 + 640; it += G) {
      if (it < 384) attn_item(wv_, p, it);
      else scan_item(wv_, p, l, it - 384);
      __syncthreads();
    }
  }
}

#define XB_TMO      128
#define XB_XCNT(j)  (256  + 64 * (j))
#define XB_XSUB(j)  (1280 + 64 * (j))
#define XB_XGEN(j)  (2304 + 64 * (j))
#define XB_TOP      3328
#define XB_TOPGEN   3392
#define XCD_BAR_WORDS 3456
#define XB_SPIN_CAP (1u << 22)
#define LAS __attribute__((address_space(3)))
DEVI unsigned xb_ld(unsigned* p) { return __hip_atomic_load(p, __ATOMIC_RELAXED, __HIP_MEMORY_SCOPE_AGENT); }
DEVI unsigned xb_add(unsigned* p, unsigned v) { return __hip_atomic_fetch_add(p, v, __ATOMIC_RELAXED, __HIP_MEMORY_SCOPE_AGENT); }
DEVI unsigned xb_xcc_id() { return (unsigned)__builtin_amdgcn_s_getreg((3 << 11) | 20) & 0xFu; }
#define XB_SPIN(cond, bar) do { unsigned _sp = 0; while (cond) { __builtin_amdgcn_s_sleep(1); \
    if ((++_sp & 255u) == 0u) { if (xb_ld(&(bar)[XB_TMO])) break; if (_sp > XB_SPIN_CAP) { atomicAdd(&(bar)[XB_TMO], 1u); break; } } } } while (0)
struct XcdBarrier { unsigned* bar; unsigned x; volatile LAS unsigned* st; };
DEVI XcdBarrier xcd_barrier_post(unsigned* bar, volatile LAS unsigned* st) {
  XcdBarrier b; b.bar = bar; b.x = xb_xcc_id(); b.st = st;
  if (threadIdx.x == 0) (void)xb_add(&bar[XB_XCNT(b.x)], 1u);
  return b;
}
DEVI void xcd_barrier_complete(unsigned* bar, unsigned x, unsigned& nloc, unsigned& nx) {
  const unsigned G = gridDim.x * gridDim.y * gridDim.z;
  unsigned sum, cnt, mine, sp = 0u;
  for (;;) {
    sum = 0u; cnt = 0u; mine = 0u;
#pragma unroll
    for (unsigned j = 0; j < 16; ++j) { const unsigned c = xb_ld(&bar[XB_XCNT(j)]); sum += c; cnt += (c > 0u) ? 1u : 0u; mine = (j == x) ? c : mine; }
    if (sum == G) break;
    __builtin_amdgcn_s_sleep(1);
    if ((++sp & 255u) == 0u) { if (xb_ld(&bar[XB_TMO])) break; if (sp > XB_SPIN_CAP) { atomicAdd(&bar[XB_TMO], 1u); break; } }
  }
  nloc = mine > 0u ? mine : 1u; nx = cnt > 0u ? cnt : 1u;
}
DEVI void xcd_barrier(const XcdBarrier& b, int wv_) {
  asm volatile("s_waitcnt vmcnt(0)" ::: "memory");
  __syncthreads();
  if (get_tid(wv_) == 0) {
    unsigned* bar = b.bar;
    __builtin_amdgcn_s_waitcnt(0);
    unsigned nloc = b.st[0], nx = b.st[1];
    if (nloc == 0u) { xcd_barrier_complete(bar, b.x, nloc, nx); b.st[0] = nloc; b.st[1] = nx; }
    const unsigned old = xb_add(&bar[XB_XSUB(b.x)], 1u);
    const unsigned gen = old / nloc;
    if (old + 1u == (gen + 1u) * nloc) {
      __builtin_amdgcn_fence(__ATOMIC_RELEASE, "agent");
      asm volatile("s_waitcnt vmcnt(0)" ::: "memory");
      const unsigned og = xb_add(&bar[XB_TOP], 1u);
      const unsigned tg = og / nx;
      if (og + 1u == (tg + 1u) * nx) xb_add(&bar[XB_TOPGEN], 1u);
      else XB_SPIN(xb_ld(&bar[XB_TOPGEN]) == tg, bar);
      __builtin_amdgcn_fence(__ATOMIC_ACQUIRE, "agent");
      xb_add(&bar[XB_XGEN(b.x)], 1u);
      asm volatile("s_waitcnt vmcnt(0)" ::: "memory");
    } else {
      XB_SPIN(xb_ld(&bar[XB_XGEN(b.x)]) == gen, bar);
      __builtin_amdgcn_fence(__ATOMIC_ACQUIRE, "agent");
      asm volatile("s_waitcnt vmcnt(0)" ::: "memory");
    }
  }
  __syncthreads();
}

__global__ void __launch_bounds__(512) fwd_megakernel(P p) {
  cg::grid_group grid = cg::this_grid();
  const int wv_ = __builtin_amdgcn_readfirstlane((int)threadIdx.x >> 6);
  char* ws = p.ws;
  volatile LAS unsigned* xbst = (volatile LAS unsigned*)&shm[65536];
  if (threadIdx.x < 4) xbst[threadIdx.x] = 0u;
  __syncthreads();
  const XcdBarrier xb = xcd_barrier_post((unsigned*)(ws + OFF_BAR), xbst);
  const u16* hbuf = (const u16*)(ws + OFF_H);
  const int NPH = 2 + 9 * NLAYER;
  for (int ph = 0; ph < NPH; ++ph) {
    if (ph == 0) {
      prep_phase(wv_, p);
    } else if (ph == 1) {
      ln_phase(wv_, p, false, 0, 0, true, 0, 0, false);
    } else {
      const int l = (ph - 2) / 9, s = (ph - 2) % 9;
      if (s == 0 || s == 7) {
        const int sub = (s == 7);
        gemm_phase<K_UP, 6>(wv_, p, hbuf, (const u16*)(ws + OFF_WUP) + (size_t)(l * 2 + sub) * 5632 * 1024, 1024, 1024, 1024, 64, 22, l, sub, 0);
        if (l + 1 < NLAYER) {
          const int bid = blockIdx.x, slot = (bid & 7) * (gridDim.x >> 3) + (bid >> 3);
          if (slot >= 128)
            convert_layer_tiles(wv_, p, l + 1, sub ? CONV_TILES / 2 : 0, sub ? CONV_TILES : CONV_TILES / 2, (slot - 128) * 8 + wv_, 1024);
        }
      } else if (s == 1 || s == 8) {
        const int sub = (s == 8);
        gemm_phase<K_DOWN, 6>(wv_, p, (const u16*)(ws + OFF_ACT), (const u16*)(ws + OFF_WDN) + (size_t)(l * 2 + sub) * 1024 * 2816, 2816, 2816, 2816, 64, 4, l, sub, 0);
      } else if (s == 2) {
        gemm_phase<K_IN, 6>(wv_, p, hbuf, (const u16*)(ws + OFF_WIN) + (size_t)l * 1792 * 1024, 1024, 1024, 1024, 64, 7, l, 0, 0);
      } else if (s == 3) {
        post_phase(wv_, p, l);
      } else if (s == 4) {
        gemm_phase<K_GATE, 8>(wv_, p, (const u16*)(ws + OFF_XC), (const u16*)(ws + OFF_WG) + (size_t)l * 8 * 256 * 64, 512, 64, 64, 48, 8, l, 0, 0);
        gemm_phase<K_KV, 8>(wv_, p, (const u16*)(ws + OFF_CKVN), (const u16*)(ws + OFF_WUKV) + (size_t)l * 1024 * 256, 256, 256, 256, 52, 4, l, 0, 128);
        gemm_phase<K_Q, 8>(wv_, p, (const u16*)(ws + OFF_CQN), (const u16*)(ws + OFF_WUQ) + (size_t)l * 768 * 384, 384, 384, 384, 48, 3, l, 0, 176);
      } else if (s == 5) {
        mixer_phase(wv_, p, l);
      } else if (s == 6) {
        gemm_phase<K_O, 6>(wv_, p, (const u16*)(ws + OFF_MIX), (const u16*)(ws + OFF_WO) + (size_t)l * 1024 * 1024, 1024, 1024, 1024, 64, 4, l, 0, 0);
      }
    }
    if (ph == 0) grid.sync();
    else if (ph + 1 < NPH) xcd_barrier(xb, wv_);
  }
}

extern "C" void kernel_launch(void* const* d_in, const int* in_sizes, int n_in, void* d_out, int out_size, void* d_ws,
                              size_t ws_size, hipStream_t stream) {
  constexpr size_t kDynLds = 131072 + 16;
  static int grid_blocks = 0;
  if (!grid_blocks) {
    hipFuncSetAttribute((const void*)fwd_megakernel, hipFuncAttributeMaxDynamicSharedMemorySize, (int)kDynLds);
    int dev = 0, cus = 0, per_cu = 0;
    hipGetDevice(&dev);
    hipDeviceGetAttribute(&cus, hipDeviceAttributeMultiprocessorCount, dev);
    hipOccupancyMaxActiveBlocksPerMultiprocessor(&per_cu, fwd_megakernel, 512, kDynLds);
    if (per_cu < 1) per_cu = 1;
    if (per_cu > 1) per_cu = 1;
    grid_blocks = cus * per_cu;
    grid_blocks &= ~7;
    if (grid_blocks != 256) fprintf(stderr, "unexpected grid %d (fused LN epilogue assumes 256)\n", grid_blocks);
    if (ws_size < WS_NEED) fprintf(stderr, "workspace too small: %zu < %zu\n", ws_size, (size_t)WS_NEED);
  }
  P p{};
  const float** pp = (const float**)&p;
  for (int i = 0; i < 26; ++i) pp[i] = (const float*)d_in[i];
  p.out = (float*)d_out;
  p.ws = (char*)d_ws;
  hipMemsetAsync((char*)d_ws + OFF_BAR, 0, 16384, stream);
  void* args[] = {&p};
  hipError_t e = hipLaunchCooperativeKernel((const void*)fwd_megakernel, dim3(grid_blocks), dim3(512), args, kDynLds, stream);
  if (e != hipSuccess) fprintf(stderr, "cooperative launch failed: %s (grid %d)\n", hipGetErrorString(e), grid_blocks);
}
```
